# Optimizing an MI355X kernel written in HIP

```python
import jax, jax.numpy as jnp
from jax import lax
import numpy as np

D_MODEL = 1024
BATCH = 16
SEQ = 2048
DEPTH = 1

D_FF = 2816
N_HEADS = 8
QK_NOPE_DIM = 64
QK_ROPE_DIM = 32
QK_HEAD_DIM = QK_NOPE_DIM + QK_ROPE_DIM
V_HEAD_DIM = 64
Q_LORA_RANK = 384
KV_LORA_RANK = 256
CONV_DIM = 1024
CONV_WIDTH = 3
ROPE_THETA = 10000.0
Q_BLOCK = 128
NORM_EPS = 1e-6
ATTN_OUT_DIM = N_HEADS * V_HEAD_DIM
N_BRANCHES = 2
IN_SIZES = (Q_LORA_RANK, KV_LORA_RANK, QK_ROPE_DIM, CONV_DIM, CONV_DIM, CONV_DIM, D_MODEL, D_MODEL)
IN_DIM = sum(IN_SIZES)
IN_SPLITS = tuple(int(s) for s in np.cumsum(IN_SIZES)[:-1])

kernel_name = "hybrid_mla_shortconv_macaron_block"


def rmsnorm(x, gain):
    x32 = x.astype(jnp.float32)
    y = x32 * lax.rsqrt(jnp.mean(x32 * x32, axis=-1, keepdims=True) + NORM_EPS)
    return (y * gain.astype(jnp.float32)).astype(x.dtype)


def swiglu(h, w_gate, w_up, w_down):
    return (jax.nn.silu(h @ w_gate) * (h @ w_up)) @ w_down


def rope(t, positions):
    half = QK_ROPE_DIM // 2
    inv_freq = 1.0 / (ROPE_THETA ** (jnp.arange(half, dtype=jnp.float32) / half))
    ang = positions.astype(jnp.float32)[..., None] * inv_freq
    ang = ang.reshape(ang.shape[:2] + (1,) * (t.ndim - 3) + (half,))
    cos, sin = jnp.cos(ang).astype(t.dtype), jnp.sin(ang).astype(t.dtype)
    t1, t2 = t[..., :half], t[..., half:]
    return jnp.concatenate([t1 * cos - t2 * sin, t1 * sin + t2 * cos], axis=-1)


def causal_block_attention(q, k, v):
    b, s, h, dq = q.shape
    nb = s // Q_BLOCK
    scale = QK_HEAD_DIM ** -0.5
    q_blocks = q.reshape(b, nb, Q_BLOCK, h, dq).transpose(1, 0, 2, 3, 4)
    key_pos = jnp.arange(s)

    def one_block(args):
        qb, blk = args
        scores = jnp.einsum('bqhd,bkhd->bhqk', qb, k).astype(jnp.float32) * scale
        q_pos = blk * Q_BLOCK + jnp.arange(Q_BLOCK)
        mask = key_pos[None, :] <= q_pos[:, None]
        scores = jnp.where(mask[None, None], scores, -1e30)
        p = jax.nn.softmax(scores, axis=-1).astype(v.dtype)
        return jnp.einsum('bhqk,bkhd->bqhd', p, v)

    out = lax.map(one_block, (q_blocks, jnp.arange(nb)))
    return out.transpose(1, 0, 2, 3, 4).reshape(b, s, h * V_HEAD_DIM)


def setup_inputs(seed: int = 0) -> dict:
    key = jax.random.key(seed)
    ks = jax.random.split(key, 32)

    def w(k, shape, fan_in):
        return jax.random.normal(k, shape, jnp.float32) * fan_in ** -0.5

    def gain(k, n):
        return 1.0 + 0.02 * jax.random.normal(k, (n,), jnp.float32)

    positions = jnp.broadcast_to(jnp.arange(SEQ, dtype=jnp.int32)[None, :], (BATCH, SEQ))
    return {
        "x": jax.random.normal(ks[0], (BATCH, SEQ, D_MODEL), jnp.float32),
        "positions": positions,
        "ffn1_norm": gain(ks[1], D_MODEL),
        "ffn1_w_gate": w(ks[2], (D_MODEL, D_FF), D_MODEL),
        "ffn1_w_up": w(ks[3], (D_MODEL, D_FF), D_MODEL),
        "ffn1_w_down": w(ks[4], (D_FF, D_MODEL), D_FF),
        "mix_norm": gain(ks[5], D_MODEL),
        "w_in": w(ks[6], (D_MODEL, IN_DIM), D_MODEL),
        "gate_bias": 0.01 * jax.random.normal(ks[7], (N_BRANCHES * D_MODEL,), jnp.float32),
        "q_a_norm": gain(ks[8], Q_LORA_RANK),
        "w_uq": w(ks[9], (Q_LORA_RANK, N_HEADS * QK_HEAD_DIM), Q_LORA_RANK),
        "kv_a_norm": gain(ks[10], KV_LORA_RANK),
        "w_uk": w(ks[11], (KV_LORA_RANK, N_HEADS * QK_NOPE_DIM), KV_LORA_RANK),
        "w_uv": w(ks[12], (KV_LORA_RANK, N_HEADS * V_HEAD_DIM), KV_LORA_RANK),
        "q_head_norm": gain(ks[13], QK_HEAD_DIM),
        "k_head_norm": gain(ks[14], QK_HEAD_DIM),
        "w_proj_attn": w(ks[15], (ATTN_OUT_DIM, D_MODEL), ATTN_OUT_DIM),
        "conv_w": w(ks[16], (CONV_WIDTH, CONV_DIM), CONV_WIDTH),
        "w_proj_conv": w(ks[17], (CONV_DIM, D_MODEL), CONV_DIM),
        "w_out": w(ks[18], (D_MODEL, D_MODEL), D_MODEL),
        "ffn2_norm": gain(ks[19], D_MODEL),
        "ffn2_w_gate": w(ks[20], (D_MODEL, D_FF), D_MODEL),
        "ffn2_w_up": w(ks[21], (D_MODEL, D_FF), D_MODEL),
        "ffn2_w_down": w(ks[22], (D_FF, D_MODEL), D_FF),
    }


def reference(x, positions, ffn1_norm, ffn1_w_gate, ffn1_w_up, ffn1_w_down,
              mix_norm, w_in, gate_bias, q_a_norm, w_uq, kv_a_norm, w_uk, w_uv,
              q_head_norm, k_head_norm, w_proj_attn, conv_w, w_proj_conv, w_out,
              ffn2_norm, ffn2_w_gate, ffn2_w_up, ffn2_w_down):
    b, s, _ = x.shape
    for _layer in range(DEPTH):
        x = x + 0.5 * swiglu(rmsnorm(x, ffn1_norm), ffn1_w_gate, ffn1_w_up, ffn1_w_down)

        h = rmsnorm(x, mix_norm)
        proj = h @ w_in
        q_lat, kv_lat, k_rope_raw, xc, gB, gC, gate_logits = jnp.split(proj, IN_SPLITS, axis=-1)[:7] + []  if False else jnp.split(proj, IN_SPLITS, axis=-1)[:7]
        gate_logits = proj[..., IN_SPLITS[-1]:] if False else jnp.concatenate([gate_logits, proj[..., IN_SPLITS[-1]:]], axis=-1)

        q = (rmsnorm(q_lat, q_a_norm) @ w_uq).reshape(b, s, N_HEADS, QK_HEAD_DIM)
        c_kv = rmsnorm(kv_lat, kv_a_norm)
        k_nope = (c_kv @ w_uk).reshape(b, s, N_HEADS, QK_NOPE_DIM)
        v = (c_kv @ w_uv).reshape(b, s, N_HEADS, V_HEAD_DIM)
        k_rope = jnp.broadcast_to(k_rope_raw[:, :, None, :], (b, s, N_HEADS, QK_ROPE_DIM))
        k = jnp.concatenate([k_nope, k_rope], axis=-1)
        q = rmsnorm(q, q_head_norm)
        k = rmsnorm(k, k_head_norm)
        q = jnp.concatenate([q[..., :QK_NOPE_DIM], rope(q[..., QK_NOPE_DIM:], positions)], axis=-1)
        k = jnp.concatenate([k[..., :QK_NOPE_DIM], rope(k[..., QK_NOPE_DIM:], positions)], axis=-1)
        y_a = causal_block_attention(q, k, v) @ w_proj_attn

        u = gC * xc
        up = jnp.pad(u, ((0, 0), (CONV_WIDTH - 1, 0), (0, 0)))
        z = conv_w[0] * up[:, :s] + conv_w[1] * up[:, 1:s + 1] + conv_w[2] * up[:, 2:s + 2]
        y_b = (gB * z) @ w_proj_conv

        gates = jax.nn.sigmoid(gate_logits + gate_bias)
        merged = gates[..., :D_MODEL] * y_a + gates[..., D_MODEL:] * y_b
        x = x + merged @ w_out

        x = x + 0.5 * swiglu(rmsnorm(x, ffn2_norm), ffn2_w_gate, ffn2_w_up, ffn2_w_down)
    return x
```

```cpp
#define MK_ONE_LAUNCH 1
#include <hip/hip_runtime.h>
#include <hip/hip_cooperative_groups.h>
#include <cstdio>
#include <cstdint>
namespace cg = cooperative_groups;
namespace pg8 {
#define PG8_LAS __attribute__((address_space(3)))
typedef unsigned short bf16_t;
typedef short bf16x8 __attribute__((ext_vector_type(8)));
typedef float f32x4 __attribute__((ext_vector_type(4)));
typedef unsigned u32x4 __attribute__((ext_vector_type(4)));
constexpr int BM = 256, BK = 64, HALF = 128, HTB = HALF * BK * 2  , STAGE_BYTES = 8 * HTB, NXCD = 8, WGM = 8;

__host__ __device__ __forceinline__ int lds_byte(int r, int c) { const int st = (r >> 4) * 2 + (c >> 5), rr = r & 15, cc = c & 31, ob = rr * 64 + cc * 2; return st * 1024 + (ob ^ (((ob >> 9) & 1) << 5)); }
__host__ __device__ __forceinline__ void stage_rc(int b, int& R, int& C) { const int st = b / 1024, sb = b % 1024, swz = sb ^ (((sb >> 9) & 1) << 5); R = (st >> 1) * 16 + swz / 64; C = (st & 1) * 32 + (swz % 64) / 2; }
__host__ __device__ __forceinline__ int perm32(int rho) { const int n = rho >> 4, i = rho & 15; return 8 * (i >> 2) + 4 * n + (i & 3); }

struct Unit { int pm, pn; };
struct Gemm { const bf16_t* A; const bf16_t* Bt; int M, N, K; };

struct StaticOrder {
    int nM, nN, nwg, G, c;
    __host__ __device__ void init(int M, int N, int G_, int c_) { nM = M / BM; nN = N / BM; nwg = nM * nN; G = G_; c = c_; }
    __host__ __device__ bool next(int i, Unit& u) const {
        const long L = (long)i * G + c; if (L >= nwg) return false;
        int wgid = (int)L; { const int q = nwg / NXCD, r = nwg % NXCD, xcd = wgid % NXCD, off = wgid / NXCD; wgid = (xcd < r ? xcd * (q + 1) : r * (q + 1) + (xcd - r) * q) + off; }
        const int nig = WGM * nN, gid = wgid / nig, fm = gid * WGM, gsz = (nM - fm) < WGM ? (nM - fm) : WGM;
        u.pm = fm + ((wgid % nig) % gsz); u.pn = (wgid % nig) / gsz; return true;
    }
    __device__ __forceinline__ void a_ready(const Unit&) const {}
    __device__ __forceinline__ void done(const Unit&) const {}
};

typedef float cvt_f32x2 __attribute__((ext_vector_type(2))); typedef __bf16 cvt_bf16x2 __attribute__((ext_vector_type(2)));
__device__ __forceinline__ unsigned cvt_pk_bf16(float lo, float hi) { const cvt_f32x2 v = {lo, hi}; const cvt_bf16x2 b = __builtin_convertvector(v, cvt_bf16x2); return __builtin_bit_cast(unsigned, b); }
typedef float f32x2 __attribute__((ext_vector_type(2)));
__device__ __forceinline__ float fast_sigmoid(float v) { return __builtin_amdgcn_rcpf(1.0f + __builtin_amdgcn_exp2f(-1.4426950408889634f * v)); }
__device__ __forceinline__ u32x4 pack8(const f32x4 v0, const f32x4 v1) { u32x4 w; w.x = cvt_pk_bf16(v0[0], v0[1]); w.y = cvt_pk_bf16(v0[2], v0[3]); w.z = cvt_pk_bf16(v1[0], v1[1]); w.w = cvt_pk_bf16(v1[2], v1[3]); return w; }
__device__ __forceinline__ float bf_lo(unsigned w) { return __uint_as_float(w << 16); }
__device__ __forceinline__ float bf_hi(unsigned w) { return __uint_as_float(w & 0xffff0000u); }
__device__ __forceinline__ void unpack8(const u32x4 w, f32x4& v0, f32x4& v1) { v0 = (f32x4){bf_lo(w.x), bf_hi(w.x), bf_lo(w.y), bf_hi(w.y)}; v1 = (f32x4){bf_lo(w.z), bf_hi(w.z), bf_lo(w.w), bf_hi(w.w)}; }

struct EpiSwiglu {
    static constexpr bool PERM = true, AFTER_DRAIN = false;
    bf16_t* H; int ldh;
    __device__ __forceinline__ void operator()(const f32x4 (&acc)[2][2][4][2], const Unit& u, int wr, int wc, int fr, int fq) const {
        const int row0 = u.pm * BM + wr * 64 + fr, col0 = u.pn * HALF + wc * 32 + 8 * fq;
#pragma unroll
        for (int ai = 0; ai < 2; ++ai)
#pragma unroll
            for (int m = 0; m < 4; ++m) {
                f32x4 h[2];
#pragma unroll
                for (int n = 0; n < 2; ++n) { const f32x4 g = acc[ai][0][m][n], up = acc[ai][1][m][n];
#pragma unroll
                    for (int i = 0; i < 4; ++i) h[n][i] = g[i] * fast_sigmoid(g[i]) * up[i]; }
                *(u32x4*)(H + (size_t)(row0 + ai * HALF + m * 16) * ldh + col0) = pack8(h[0], h[1]);
            }
    }
};
struct EpiResF32 {
    static constexpr bool PERM = false, AFTER_DRAIN = false;
    const float* base; float* out; int ldc; float scale;
    __device__ __forceinline__ void operator()(const f32x4 (&acc)[2][2][4][2], const Unit& u, int wr, int wc, int fr, int fq) const {
        const int row0 = u.pm * BM + wr * 64 + fr, col0 = u.pn * BM + wc * 32 + 4 * fq;
#pragma unroll
        for (int ai = 0; ai < 2; ++ai)
#pragma unroll
            for (int m = 0; m < 4; ++m) { const size_t off = (size_t)(row0 + ai * HALF + m * 16) * ldc + col0;
#pragma unroll
                for (int bj = 0; bj < 2; ++bj)
#pragma unroll
                    for (int n = 0; n < 2; ++n) { const f32x4 b = *(const f32x4*)(base + off + bj * HALF + n * 16); *(f32x4*)(out + off + bj * HALF + n * 16) = b + acc[ai][bj][m][n] * scale; }
                if (m & 1) asm volatile("" ::: "memory"); }
    }
};
template <bool REMAP> struct EpiBf16 {
    static constexpr bool PERM = true, AFTER_DRAIN = false;
    bf16_t* O; int ldc;
    __device__ __forceinline__ void operator()(const f32x4 (&acc)[2][2][4][2], const Unit& u, int wr, int wc, int fr, int fq) const {
        const int row0 = u.pm * BM + wr * 64 + fr, c0 = u.pn * BM + wc * 32 + 8 * fq;
#pragma unroll
        for (int ai = 0; ai < 2; ++ai)
#pragma unroll
            for (int m = 0; m < 4; ++m) { bf16_t* rowp = O + (size_t)(row0 + ai * HALF + m * 16) * ldc;
#pragma unroll
                for (int bj = 0; bj < 2; ++bj) { const int c = c0 + bj * HALF; const int dc = REMAP ? ((c >> 6) * 96 + (c & 63)) : c;
                    *(u32x4*)(rowp + dc) = pack8(acc[ai][bj][m][0], acc[ai][bj][m][1]); } }
    }
};
struct EpiWin {
    static constexpr bool PERM = true, AFTER_DRAIN = false;
    bf16_t *LAT, *U, *GB, *GATES; const float* gate_bias;
    __device__ __forceinline__ void operator()(const f32x4 (&acc)[2][2][4][2], const Unit& u, int wr, int wc, int fr, int fq) const {
        const int row0 = u.pm * BM + wr * 64 + fr, cw = wc * 32 + 8 * fq; const int pn = u.pn;
        if (pn >= 3 && pn < 11) {
#pragma unroll
            for (int ai = 0; ai < 2; ++ai)
#pragma unroll
                for (int m = 0; m < 4; ++m)
                    *(u32x4*)(U + (size_t)(row0 + ai * HALF + m * 16) * 1024 + (pn - 3) * HALF + cw) = pack8(acc[ai][0][m][0] * acc[ai][1][m][0], acc[ai][0][m][1] * acc[ai][1][m][1]);
        } else if (pn >= 15) {
            f32x4 bv[2][2];
#pragma unroll
            for (int bj = 0; bj < 2; ++bj)
#pragma unroll
                for (int n = 0; n < 2; ++n) bv[bj][n] = *(const f32x4*)(gate_bias + (pn - 15) * BM + bj * HALF + cw + 4 * n);
#pragma unroll
            for (int ai = 0; ai < 2; ++ai)
#pragma unroll
                for (int m = 0; m < 4; ++m)
#pragma unroll
                    for (int bj = 0; bj < 2; ++bj) { f32x4 s[2];
#pragma unroll
                        for (int n = 0; n < 2; ++n) { const f32x4 v = acc[ai][bj][m][n] + bv[bj][n];
#pragma unroll
                            for (int i = 0; i < 4; ++i) s[n][i] = fast_sigmoid(v[i]); }
                        *(u32x4*)(GATES + (size_t)(row0 + ai * HALF + m * 16) * 2048 + (pn - 15) * BM + bj * HALF + cw) = pack8(s[0], s[1]); }
        } else {
            bf16_t* O = pn < 3 ? LAT : GB; const int ldc = pn < 3 ? 768 : 1024; const int ct = pn < 3 ? pn * BM : (pn - 11) * BM;
#pragma unroll
            for (int ai = 0; ai < 2; ++ai)
#pragma unroll
                for (int m = 0; m < 4; ++m)
#pragma unroll
                    for (int bj = 0; bj < 2; ++bj)
                        *(u32x4*)(O + (size_t)(row0 + ai * HALF + m * 16) * ldc + ct + bj * HALF + cw) = pack8(acc[ai][bj][m][0], acc[ai][bj][m][1]);
        }
    }
};
template <bool ADD> struct EpiGate {
    static constexpr bool PERM = true, AFTER_DRAIN = false;
    bf16_t* Mg; const bf16_t* G; int ldg; const bf16_t* Prev;
    __device__ __forceinline__ void operator()(const f32x4 (&acc)[2][2][4][2], const Unit& u, int wr, int wc, int fr, int fq) const {
        const int row0 = u.pm * BM + wr * 64 + fr, c0 = u.pn * BM + wc * 32 + 8 * fq;
#pragma unroll
        for (int ai = 0; ai < 2; ++ai)
#pragma unroll
            for (int m = 0; m < 4; ++m) { const size_t r = (size_t)(row0 + ai * HALF + m * 16);
#pragma unroll
                for (int bj = 0; bj < 2; ++bj) { const int c = c0 + bj * HALF;
                    f32x4 g0, g1; unpack8(*(const u32x4*)(G + r * ldg + c), g0, g1);
                    f32x4 v0 = g0 * acc[ai][bj][m][0], v1 = g1 * acc[ai][bj][m][1];
                    if (ADD) { f32x4 p0, p1; unpack8(*(const u32x4*)(Prev + r * 1024 + c), p0, p1); v0 += p0; v1 += p1; }
                    *(u32x4*)(Mg + r * 1024 + c) = pack8(v0, v1); } }
    }
};

struct EpiKnorm {
    static constexpr bool PERM = true, AFTER_DRAIN = false;
    bf16_t* K; const bf16_t* LAT; const float* CS; const float* gk;
    __device__ __forceinline__ void operator()(const f32x4 (&acc)[2][2][4][2], const Unit& u, int wr, int wc, int fr, int fq) const {
        typedef unsigned u32x2e __attribute__((ext_vector_type(2)));
        const int head = u.pn * 4 + wc, row0 = u.pm * BM + wr * 64 + fr;
        f32x4 gn[2][2];
#pragma unroll
        for (int bj = 0; bj < 2; ++bj)
#pragma unroll
            for (int n = 0; n < 2; ++n) gn[bj][n] = *(const f32x4*)(gk + 32 * bj + 8 * fq + 4 * n);
        const f32x4 g1 = *(const f32x4*)(gk + 64 + 4 * fq), g2 = *(const f32x4*)(gk + 80 + 4 * fq);
#pragma unroll
        for (int ai = 0; ai < 2; ++ai)
#pragma unroll
            for (int m = 0; m < 4; ++m) {
                const size_t row = (size_t)(row0 + ai * HALF + m * 16);
                const u32x2e w1 = *(const u32x2e*)(LAT + row * 768 + 640 + 4 * fq), w2 = *(const u32x2e*)(LAT + row * 768 + 656 + 4 * fq);
                f32x4 t1 = (f32x4){bf_lo(w1.x), bf_hi(w1.x), bf_lo(w1.y), bf_hi(w1.y)}, t2 = (f32x4){bf_lo(w2.x), bf_hi(w2.x), bf_lo(w2.y), bf_hi(w2.y)};
                const f32x4 cs = *(const f32x4*)(CS + row * 32 + 4 * fq), sn = *(const f32x4*)(CS + row * 32 + 16 + 4 * fq);
                float ss = (t1[0] * t1[0] + t1[1] * t1[1]) + (t1[2] * t1[2] + t1[3] * t1[3]) + (t2[0] * t2[0] + t2[1] * t2[1]) + (t2[2] * t2[2] + t2[3] * t2[3]);
#pragma unroll
                for (int bj = 0; bj < 2; ++bj)
#pragma unroll
                    for (int n = 0; n < 2; ++n) { const f32x4 a = acc[ai][bj][m][n]; ss += (a[0] * a[0] + a[1] * a[1]) + (a[2] * a[2] + a[3] * a[3]); }
                ss += __shfl_xor(ss, 16); ss += __shfl_xor(ss, 32);
                const float rstd = 1.0f / sqrtf(ss * (1.0f / 96.0f) + 1e-6f);
                bf16_t* kr = K + row * 768 + 96 * head;
#pragma unroll
                for (int bj = 0; bj < 2; ++bj)
                    *(u32x4*)(kr + 32 * bj + 8 * fq) = pack8(acc[ai][bj][m][0] * rstd * gn[bj][0], acc[ai][bj][m][1] * rstd * gn[bj][1]);
                t1 = t1 * rstd * g1; t2 = t2 * rstd * g2;
                const f32x4 o1 = t1 * cs - t2 * sn, o2 = t1 * sn + t2 * cs;
                u32x2e p1, p2; p1.x = cvt_pk_bf16(o1[0], o1[1]); p1.y = cvt_pk_bf16(o1[2], o1[3]); p2.x = cvt_pk_bf16(o2[0], o2[1]); p2.y = cvt_pk_bf16(o2[2], o2[3]);
                *(u32x2e*)(kr + 64 + 4 * fq) = p1; *(u32x2e*)(kr + 80 + 4 * fq) = p2;
            }
    }
};
template <class Epi, class Sched, bool ALIGN_EPI = false, bool SP2 = false>
__device__ __forceinline__ void gemm_phase(PG8_LAS unsigned char* lds, const Gemm g, const Sched& S, const Epi& E) {
    const int tid = threadIdx.x, wid = __builtin_amdgcn_readfirstlane(tid >> 6), lane = tid & 63, wr = wid >> 2, wc = wid & 3, fr = lane & 15, fq = lane >> 4;
    const int K = g.K, nt = K / BK;
    unsigned voffA[2], voffB[2];
#pragma unroll
    for (int i = 0; i < 2; ++i) { int R, C; stage_rc(tid * 16 + i * 8192, R, C); const int Rb = Epi::PERM ? ((R & ~31) + perm32(R & 31)) : R;
        voffA[i] = (unsigned)(R * K + C) * 2u; voffB[i] = (unsigned)(Rb * K + C) * 2u; }
    const size_t kstep = (size_t)(BK * 2);
    const size_t hstep = (size_t)HALF * K * 2;
    const size_t tstep = 2 * hstep;
    const unsigned ldsw = (unsigned)wid * 1024u;
    const int aoff = lds_byte(wr * 64 + fr, fq * 8), boff = lds_byte(wc * 32 + fr, fq * 8);
#define PG8_SA(b, h) (((b) * 2 + (h)) * HTB)
#define PG8_SB(b, h) ((4 + (b) * 2 + (h)) * HTB)
#define PG8_STAGE(bufoff, gbase, voff) do { _Pragma("unroll") for (int _i = 0; _i < 2; ++_i) \
        __builtin_amdgcn_global_load_lds((const unsigned*)((const char*)(gbase) + (voff)[_i]), (PG8_LAS unsigned*)(lds + (bufoff) + ldsw + _i * 8192), 16, 0, 0); } while (0)
#define PG8_LDA(dst, b, h) do { _Pragma("unroll") for (int m = 0; m < 4; ++m) _Pragma("unroll") for (int k = 0; k < 2; ++k) dst[m][k] = *(const PG8_LAS bf16x8*)(lds + PG8_SA(b, h) + aoff + m * 2048 + k * 1024); } while (0)
#define PG8_LDB(dst, b, h) do { _Pragma("unroll") for (int n = 0; n < 2; ++n) _Pragma("unroll") for (int k = 0; k < 2; ++k) dst[n][k] = *(const PG8_LAS bf16x8*)(lds + PG8_SB(b, h) + boff + n * 2048 + k * 1024); } while (0)
#define PG8_MMA(ai, bj, At, Bt) do { __builtin_amdgcn_s_setprio(1); _Pragma("unroll") for (int m = 0; m < 4; ++m) _Pragma("unroll") for (int n = 0; n < 2; ++n) _Pragma("unroll") for (int k = 0; k < 2; ++k) \
        acc[ai][bj][m][n] = __builtin_amdgcn_mfma_f32_16x16x32_bf16(Bt[n][k], At[m][k], acc[ai][bj][m][n], 0, 0, 0); __builtin_amdgcn_s_setprio(0); } while (0)
#define PG8_WAIT_V(n) asm volatile("s_waitcnt vmcnt(" #n ")" ::: "memory")
#define PG8_WAIT_L(n) asm volatile("s_waitcnt lgkmcnt(" #n ")" ::: "memory")
#define PG8_BAR __builtin_amdgcn_s_barrier()
#define PG8_SCHED __builtin_amdgcn_sched_barrier(0)
    Unit cur, nxt; int ui = 0;
    if (!S.next(0, cur)) return;
    f32x4 acc[2][2][4][2];
#pragma unroll
    for (int a = 0; a < 2; ++a)
#pragma unroll
        for (int b = 0; b < 2; ++b)
#pragma unroll
            for (int m = 0; m < 4; ++m)
#pragma unroll
                for (int n = 0; n < 2; ++n) acc[a][b][m][n] = (f32x4){0.f, 0.f, 0.f, 0.f};
    bf16x8 At[4][2], B0[2][2], B1[2][2];
    const char* cA = (const char*)g.A + (size_t)cur.pm * tstep; const char* cB = (const char*)g.Bt + (size_t)cur.pn * tstep;
    S.a_ready(cur);
    if constexpr (SP2) {
        PG8_STAGE(PG8_SB(0, 0), cB, voffB); PG8_STAGE(PG8_SB(0, 1), cB + hstep, voffB); PG8_STAGE(PG8_SA(0, 0), cA, voffA); PG8_STAGE(PG8_SA(0, 1), cA + hstep, voffA);
        if (wr == 1) PG8_BAR;
        PG8_WAIT_V(2); PG8_BAR;
        PG8_STAGE(PG8_SB(1, 0), cB + kstep, voffB); PG8_STAGE(PG8_SA(1, 0), cA + kstep, voffA); PG8_STAGE(PG8_SB(1, 1), cB + hstep + kstep, voffB);
        PG8_WAIT_V(6); PG8_BAR;
    } else {
        PG8_STAGE(PG8_SB(0, 0), cB, voffB); PG8_STAGE(PG8_SA(0, 0), cA, voffA); PG8_STAGE(PG8_SB(0, 1), cB + hstep, voffB); PG8_STAGE(PG8_SA(0, 1), cA + hstep, voffA);
        if (wr == 1) PG8_BAR;
        PG8_WAIT_V(4); PG8_BAR;
        PG8_STAGE(PG8_SB(1, 0), cB + kstep, voffB); PG8_STAGE(PG8_SA(1, 0), cA + kstep, voffA); PG8_STAGE(PG8_SB(1, 1), cB + hstep + kstep, voffB);
        PG8_WAIT_V(6); PG8_BAR;
    }
    for (;;) {
        const bool has_next = S.next(ui + 1, nxt);
        const char* nA = has_next ? (const char*)g.A + (size_t)nxt.pm * tstep : cA; const char* nB = has_next ? (const char*)g.Bt + (size_t)nxt.pn * tstep : cB;
_Pragma("unroll 1")
        for (int t = 0; t < nt; t += 2) {
            const bool last = (t == nt - 2);
            const char* a1 = cA + (size_t)(t + 1) * kstep;
            const char* a2 = last ? nA : cA + (size_t)(t + 2) * kstep; const char* b2 = last ? nB : cB + (size_t)(t + 2) * kstep;
            const char* a3 = a2 + kstep; const char* b3 = b2 + kstep;
            if (last && has_next) S.a_ready(nxt);
            if constexpr (SP2) {
            PG8_LDB(B0, 0, 0); PG8_LDB(B1, 0, 1); PG8_SCHED; PG8_LDA(At, 0, 0); PG8_STAGE(PG8_SA(1, 1), a1 + hstep, voffA);
            PG8_WAIT_V(8); PG8_WAIT_L(0); PG8_BAR; PG8_MMA(0, 0, At, B0); PG8_MMA(0, 1, At, B1); PG8_BAR; PG8_SCHED;
            PG8_LDA(At, 0, 1); PG8_STAGE(PG8_SB(0, 0), b2, voffB); PG8_STAGE(PG8_SB(0, 1), b2 + hstep, voffB); PG8_STAGE(PG8_SA(0, 0), a2, voffA);
            PG8_WAIT_V(8); PG8_WAIT_L(0); PG8_BAR; PG8_MMA(1, 0, At, B0); PG8_MMA(1, 1, At, B1); PG8_BAR; PG8_SCHED;
            PG8_LDB(B0, 1, 0); PG8_LDB(B1, 1, 1); PG8_SCHED; PG8_LDA(At, 1, 0); PG8_STAGE(PG8_SA(0, 1), a2 + hstep, voffA);
            PG8_WAIT_V(8); PG8_WAIT_L(0); PG8_BAR; PG8_MMA(0, 0, At, B0); PG8_MMA(0, 1, At, B1); PG8_BAR; PG8_SCHED;
            PG8_LDA(At, 1, 1); PG8_STAGE(PG8_SB(1, 0), b3, voffB); PG8_STAGE(PG8_SB(1, 1), b3 + hstep, voffB); PG8_STAGE(PG8_SA(1, 0), a3, voffA);
            PG8_WAIT_V(8); PG8_WAIT_L(0); PG8_BAR; PG8_MMA(1, 0, At, B0); PG8_MMA(1, 1, At, B1); PG8_BAR; PG8_SCHED;
            } else {
            PG8_LDB(B0, 0, 0); PG8_SCHED; PG8_LDA(At, 0, 0); PG8_STAGE(PG8_SA(1, 1), a1 + hstep, voffA);
            PG8_WAIT_L(8); PG8_BAR; PG8_WAIT_L(0); PG8_MMA(0, 0, At, B0); PG8_BAR; PG8_SCHED;
            PG8_LDB(B1, 0, 1); PG8_STAGE(PG8_SB(0, 0), b2, voffB);
            PG8_BAR; PG8_WAIT_L(0); PG8_MMA(0, 1, At, B1); PG8_BAR;
            PG8_LDA(At, 0, 1); PG8_STAGE(PG8_SA(0, 0), a2, voffA);
            PG8_BAR; PG8_WAIT_L(0); PG8_MMA(1, 0, At, B0); PG8_BAR; PG8_SCHED;
            PG8_STAGE(PG8_SB(0, 1), b2 + hstep, voffB);
            PG8_WAIT_V(6); PG8_BAR; PG8_MMA(1, 1, At, B1); PG8_BAR;
            PG8_LDB(B0, 1, 0); PG8_SCHED; PG8_LDA(At, 1, 0); PG8_STAGE(PG8_SA(0, 1), a2 + hstep, voffA);
            PG8_WAIT_L(8); PG8_BAR; PG8_WAIT_L(0); PG8_MMA(0, 0, At, B0); PG8_BAR; PG8_SCHED;
            PG8_LDB(B1, 1, 1); PG8_STAGE(PG8_SB(1, 0), b3, voffB);
            PG8_BAR; PG8_WAIT_L(0); PG8_MMA(0, 1, At, B1); PG8_BAR;
            PG8_LDA(At, 1, 1); PG8_STAGE(PG8_SA(1, 0), a3, voffA);
            PG8_BAR; PG8_WAIT_L(0); PG8_MMA(1, 0, At, B0); PG8_BAR; PG8_SCHED;
            PG8_STAGE(PG8_SB(1, 1), b3 + hstep, voffB);
            PG8_WAIT_V(6); PG8_BAR; PG8_MMA(1, 1, At, B1); PG8_BAR;
            }
        }
        if constexpr (ALIGN_EPI) { if (wr == 0) PG8_BAR; }
        if constexpr (!Epi::AFTER_DRAIN) { E(acc, cur, wr, wc, fr, fq); S.done(cur); }
        if (!has_next) break;
#pragma unroll
        for (int a = 0; a < 2; ++a)
#pragma unroll
            for (int b = 0; b < 2; ++b)
#pragma unroll
                for (int m = 0; m < 4; ++m)
#pragma unroll
                    for (int n = 0; n < 2; ++n) acc[a][b][m][n] = (f32x4){0.f, 0.f, 0.f, 0.f};
        cur = nxt; cA = nA; cB = nB; ++ui;
        if constexpr (ALIGN_EPI) { if (wr == 1) PG8_BAR; }
    }
    PG8_WAIT_V(0);
    if constexpr (!ALIGN_EPI) { if (wr == 0) PG8_BAR; }
    PG8_BAR;
    if constexpr (Epi::AFTER_DRAIN) { E.fused(acc, cur, wr, wc, fr, fq, lds, wid, lane); S.done(cur); }
#undef PG8_SA
#undef PG8_SB
#undef PG8_STAGE
#undef PG8_LDA
#undef PG8_LDB
#undef PG8_MMA
#undef PG8_WAIT_V
#undef PG8_WAIT_L
#undef PG8_BAR
#undef PG8_SCHED
}
}

#define LAS __attribute__((address_space(3)))
typedef unsigned short bf16;
typedef unsigned u32x4 __attribute__((ext_vector_type(4)));
typedef unsigned u32x2 __attribute__((ext_vector_type(2)));
typedef float f32x4 __attribute__((ext_vector_type(4)));
typedef float f32x16 __attribute__((ext_vector_type(16)));
typedef short bf16x8 __attribute__((ext_vector_type(8)));
typedef short s16x4 __attribute__((ext_vector_type(4)));
constexpr int NWAVES = 8;
typedef unsigned short bf16_fwd_unused;
#define XB_TMO      128
#define XB_XCNT(j)  (256  + 64 * (j))
#define XB_XSUB(j)  (1280 + 64 * (j))
#define XB_XGEN(j)  (2304 + 64 * (j))
#define XB_TOP      3328
#define XB_TOPGEN   3392
#define XCD_BAR_WORDS 3456
#define XB_SPIN_CAP (1u << 18)

__device__ __forceinline__ unsigned xb_ld(unsigned* p)              { return __hip_atomic_load(p, __ATOMIC_RELAXED, __HIP_MEMORY_SCOPE_AGENT); }
__device__ __forceinline__ unsigned xb_add(unsigned* p, unsigned v) { return __hip_atomic_fetch_add(p, v, __ATOMIC_RELAXED, __HIP_MEMORY_SCOPE_AGENT); }
__device__ __forceinline__ unsigned xb_xcc_id() { return (unsigned)__builtin_amdgcn_s_getreg((3 << 11) | 20) & 0xFu; }
#define XB_SPIN(cond, bar) do { unsigned _sp = 0; while (cond) { __builtin_amdgcn_s_sleep(1); \
    if ((++_sp & 255u) == 0u) { if (xb_ld(&(bar)[XB_TMO])) break; if (_sp > XB_SPIN_CAP) { atomicAdd(&(bar)[XB_TMO], 1u); break; } } } } while (0)

struct XcdBarrier {
    unsigned* bar; unsigned x;
    volatile LAS unsigned* st;
};

__device__ __forceinline__ XcdBarrier xcd_barrier_post(unsigned* bar, volatile LAS unsigned* st) {
    XcdBarrier b; b.bar = bar; b.x = xb_xcc_id(); b.st = st;
    if (threadIdx.x == 0) (void)xb_add(&bar[XB_XCNT(b.x)], 1u);
    return b;
}
__device__ __forceinline__ void xcd_barrier_complete(unsigned* bar, unsigned x, unsigned& nloc, unsigned& nx) {
    const unsigned G = gridDim.x * gridDim.y * gridDim.z;
    unsigned sum, cnt, mine, sp = 0u;
    for (;;) {
        sum = 0u; cnt = 0u; mine = 0u;
#pragma unroll
        for (unsigned j = 0; j < 16; ++j) { const unsigned c = xb_ld(&bar[XB_XCNT(j)]); sum += c; cnt += (c > 0u) ? 1u : 0u; mine = (j == x) ? c : mine; }
        if (sum == G) break;
        __builtin_amdgcn_s_sleep(1);
        if ((++sp & 255u) == 0u) { if (xb_ld(&bar[XB_TMO])) break; if (sp > XB_SPIN_CAP) { atomicAdd(&bar[XB_TMO], 1u); break; } }
    }
    nloc = mine > 0u ? mine : 1u; nx = cnt > 0u ? cnt : 1u;
}

__device__ __forceinline__ void xcd_barrier(const XcdBarrier& b) {
    asm volatile("s_waitcnt vmcnt(0)" ::: "memory");
    __syncthreads();
    if (threadIdx.x == 0) {
        unsigned* bar = b.bar;
        __builtin_amdgcn_s_waitcnt(0);
        unsigned nloc = b.st[0], nx = b.st[1];
        if (nloc == 0u) { xcd_barrier_complete(bar, b.x, nloc, nx); b.st[0] = nloc; b.st[1] = nx; }
        const unsigned old = xb_add(&bar[XB_XSUB(b.x)], 1u);
        const unsigned gen = old / nloc;
        if (old + 1u == (gen + 1u) * nloc) {
            __builtin_amdgcn_fence(__ATOMIC_RELEASE, "agent");
            asm volatile("s_waitcnt vmcnt(0)" ::: "memory");
            const unsigned og = xb_add(&bar[XB_TOP], 1u);
            const unsigned tg = og / nx;
            if (og + 1u == (tg + 1u) * nx) xb_add(&bar[XB_TOPGEN], 1u);
            else XB_SPIN(xb_ld(&bar[XB_TOPGEN]) == tg, bar);
            __builtin_amdgcn_fence(__ATOMIC_ACQUIRE, "agent");
            xb_add(&bar[XB_XGEN(b.x)], 1u);
            asm volatile("s_waitcnt vmcnt(0)" ::: "memory");
        } else {
            XB_SPIN(xb_ld(&bar[XB_XGEN(b.x)]) == gen, bar);
            __builtin_amdgcn_fence(__ATOMIC_ACQUIRE, "agent");
            asm volatile("s_waitcnt vmcnt(0)" ::: "memory");
        }
    }
    __syncthreads();
}

constexpr int T = 32768, D = 1024, FF = 2816, SEQ = 2048, NH = 8;
constexpr int NIN = 5792, NINP = 5888;
constexpr float EPS = 1e-6f;
constexpr size_t MiB = 1u << 20;
constexpr size_t WS_W1GU = 1 * MiB;
constexpr size_t WS_W1D = WS_W1GU + 11 * MiB;
constexpr size_t WS_WIN = WS_W1D + 6 * MiB;
constexpr size_t WS_WUQ = WS_WIN + 12 * MiB;
constexpr size_t WS_WUK = WS_WUQ + 1 * MiB;
constexpr size_t WS_WUV = WS_WUK + 1 * MiB;
constexpr size_t WS_WPA = WS_WUV + 1 * MiB;
constexpr size_t WS_WPC = WS_WPA + 1 * MiB;
constexpr size_t WS_WOUT = WS_WPC + 2 * MiB;
constexpr size_t WS_W2GU = WS_WOUT + 2 * MiB;
constexpr size_t WS_W2D = WS_W2GU + 11 * MiB;
static_assert(WS_W2D + 6 * MiB <= 56 * MiB, "weights");
constexpr size_t WS_XN = 56 * MiB;
constexpr size_t WS_ZB = WS_XN;
constexpr size_t WS_H = 120 * MiB;
constexpr size_t WS_U = 120 * MiB, WS_GB = 184 * MiB, WS_LAT = 248 * MiB;
constexpr size_t WS_GATES = 296 * MiB;
constexpr size_t WS_QN = 424 * MiB, WS_CKV = 448 * MiB;
constexpr size_t WS_Q = 120 * MiB, WS_K = 168 * MiB, WS_VT = 216 * MiB;
constexpr size_t WS_AO = 464 * MiB;
constexpr size_t WS_MG = 120 * MiB;
constexpr size_t WS_CS = 496 * MiB;
constexpr size_t WS_END = 500 * MiB;
constexpr int LDS_BYTES = 147456;

__device__ __forceinline__ unsigned f2bf(float f) { unsigned u = __builtin_bit_cast(unsigned, f); return (u + 0x7fffu + ((u >> 16) & 1u)) >> 16; }
__device__ __forceinline__ unsigned pk2(float lo, float hi) { return pg8::cvt_pk_bf16(lo, hi); }
__device__ __forceinline__ float bflo(unsigned w) { return __uint_as_float(w << 16); }
__device__ __forceinline__ float bfhi(unsigned w) { return __uint_as_float(w & 0xffff0000u); }
__device__ __forceinline__ float wave_sum(float v) {
#pragma unroll
    for (int o = 1; o < 64; o <<= 1) v += __shfl_xor(v, o);
    return v;
}
#define LDS_WAIT() asm volatile("s_waitcnt lgkmcnt(0)" ::: "memory")

enum { MAP_ID = 0, MAP_GATE = 1, MAP_UP = 2, MAP_WIN = 3, MAP_UK = 4 };
__device__ __forceinline__ int map_row(int mode, int n0) {
    if (mode == MAP_GATE) return 256 * (n0 >> 7) + (n0 & 127);
    if (mode == MAP_UP) return 256 * (n0 >> 7) + 128 + (n0 & 127);
    if (mode == MAP_UK) { const int head = n0 >> 6, dim = n0 & 63; return 256 * (head >> 2) + 128 * (dim >> 5) + 32 * (head & 3) + (dim & 31); }
    if (mode == MAP_WIN) {
        if (n0 < 672) return n0;
        if (n0 < 1696) { const int j = n0 - 672; return 256 * (3 + (j >> 7)) + (j & 127); }
        if (n0 < 2720) { return 256 * 11 + (n0 - 1696); }
        if (n0 < 3744) { const int j = n0 - 2720; return 256 * (3 + (j >> 7)) + 128 + (j & 127); }
        return 256 * 15 + (n0 - 3744);
    }
    return n0;
}
__device__ __forceinline__ void p0_transpose_item(const float* W, int K, int N, bf16* WT, int mode, LAS float* scr, int item, int lane) {
    const int nblk = N / 32, kb = item / nblk, nb = item % nblk, k0 = 64 * kb, n0 = 32 * nb;
    const int r0 = map_row(mode, n0);
    float wv[32];
    { const float* wp = W + (size_t)(k0 + (lane >> 5)) * N + n0 + (lane & 31);
#pragma unroll
      for (int i = 0; i < 32; ++i) wv[i] = wp[(size_t)(2 * i) * N]; }
#pragma unroll
    for (int i = 0; i < 32; ++i) scr[(2 * i + (lane >> 5)) * 33 + (lane & 31)] = wv[i];
    LDS_WAIT(); asm volatile("" ::: "memory");
    const int c = lane & 7;
#pragma unroll
    for (int j = 0; j < 4; ++j) { const int n = (lane >> 3) + 8 * j; const LAS float* s = scr + (8 * c) * 33 + n;
        u32x4 o; o.x = pk2(s[0 * 33], s[1 * 33]); o.y = pk2(s[2 * 33], s[3 * 33]); o.z = pk2(s[4 * 33], s[5 * 33]); o.w = pk2(s[6 * 33], s[7 * 33]);
        *(u32x4*)(WT + (size_t)(r0 + n) * K + k0 + 8 * c) = o; }
    LDS_WAIT(); asm volatile("" ::: "memory");
}
__device__ __forceinline__ void rms_row_to_bf16(const float* xrow, const float* gain, bf16* orow, int lane) {
    const f32x4* xr = (const f32x4*)xrow + lane; const f32x4* gr = (const f32x4*)gain + lane;
    f32x4 v[4]; float s = 0.f;
#pragma unroll
    for (int j = 0; j < 4; ++j) { v[j] = xr[64 * j]; s += (v[j].x * v[j].x + v[j].y * v[j].y) + (v[j].z * v[j].z + v[j].w * v[j].w); }
    const float rstd = 1.0f / sqrtf(wave_sum(s) * (1.f / 1024.f) + EPS);
    u32x2* o8 = (u32x2*)orow + lane;
#pragma unroll
    for (int j = 0; j < 4; ++j) { const f32x4 g = gr[64 * j]; u32x2 w; w.x = pk2(v[j].x * rstd * g.x, v[j].y * rstd * g.y); w.y = pk2(v[j].z * rstd * g.z, v[j].w * rstd * g.w); o8[64 * j] = w; }
}

__device__ __forceinline__ void rms_rows2_to_bf16(const float* xa, const float* xb, const float* gain, bf16* oa, bf16* ob, int lane) {
    const f32x4* xr0 = (const f32x4*)xa + lane; const f32x4* xr1 = (const f32x4*)xb + lane; const f32x4* gr = (const f32x4*)gain + lane;
    f32x4 v0[4], v1[4]; float s0 = 0.f, s1 = 0.f;
#pragma unroll
    for (int j = 0; j < 4; ++j) { v0[j] = xr0[64 * j]; v1[j] = xr1[64 * j]; }
#pragma unroll
    for (int j = 0; j < 4; ++j) { s0 += (v0[j].x * v0[j].x + v0[j].y * v0[j].y) + (v0[j].z * v0[j].z + v0[j].w * v0[j].w); s1 += (v1[j].x * v1[j].x + v1[j].y * v1[j].y) + (v1[j].z * v1[j].z + v1[j].w * v1[j].w); }
#pragma unroll
    for (int o = 1; o < 64; o <<= 1) { s0 += __shfl_xor(s0, o); s1 += __shfl_xor(s1, o); }
    const float r0 = 1.0f / sqrtf(s0 * (1.f / 1024.f) + EPS), r1 = 1.0f / sqrtf(s1 * (1.f / 1024.f) + EPS);
    u32x2* o0 = (u32x2*)oa + lane; u32x2* o1 = (u32x2*)ob + lane;
#pragma unroll
    for (int j = 0; j < 4; ++j) { const f32x4 g = gr[64 * j]; u32x2 w; w.x = pk2(v0[j].x * r0 * g.x, v0[j].y * r0 * g.y); w.y = pk2(v0[j].z * r0 * g.z, v0[j].w * r0 * g.w); o0[64 * j] = w;
        w.x = pk2(v1[j].x * r1 * g.x, v1[j].y * r1 * g.y); w.y = pk2(v1[j].z * r1 * g.z, v1[j].w * r1 * g.w); o1[64 * j] = w; }
}
__device__ __forceinline__ void rms_pass(const float* src, const float* gain, bf16* dst, int gw, int NGW, int lane) {
    int m = gw;
    for (; m + NGW < T; m += 2 * NGW) rms_rows2_to_bf16(src + (size_t)m * D, src + (size_t)(m + NGW) * D, gain, dst + (size_t)m * D, dst + (size_t)(m + NGW) * D, lane);
    if (m < T) rms_row_to_bf16(src + (size_t)m * D, gain, dst + (size_t)m * D, lane);
}

namespace att {
constexpr int QP = 768, OP = 512;
constexpr int KSTR = 208, VSTR = 144, OSTR = 144;
constexpr int KBUF = 64 * KSTR, VBUF = 64 * VSTR;
constexpr int L_K = 0, L_V = 2 * KBUF, L_OST = L_V + 2 * VBUF, L_END = L_OST + 8 * 32 * OSTR;
static_assert(L_END <= 131072, "attention LDS");
__device__ __forceinline__ int crow(int r, int hi) { return (r & 3) + 8 * (r >> 2) + 4 * hi; }
__device__ __forceinline__ void attn_unit(int b, int h, int qb, const bf16* Q, const bf16* K, const bf16* VT, bf16* O, const float* qhn, const float* CS, LAS unsigned char* lds) {
    const int tid = threadIdx.x, lane = tid & 63, r32 = lane & 31, hi = lane >> 5; const int wid = __builtin_amdgcn_readfirstlane(tid >> 6);
    const size_t rowbase = (size_t)b * SEQ; const int q0 = qb * 256, qw = q0 + wid * 32;
    bf16x8 qf[6];
    {
      const size_t qrow = rowbase + qw + r32;
      const bf16* qp = Q + qrow * QP + h * 96 + hi * 8;
      u32x4 raw[6];
#pragma unroll
      for (int ks = 0; ks < 6; ++ks) raw[ks] = *(const u32x4*)(qp + ks * 16);
      const f32x4 c0 = *(const f32x4*)(CS + qrow * 32 + 8 * hi), c1 = *(const f32x4*)(CS + qrow * 32 + 8 * hi + 4), s0 = *(const f32x4*)(CS + qrow * 32 + 16 + 8 * hi), s1 = *(const f32x4*)(CS + qrow * 32 + 16 + 8 * hi + 4);
      float v[6][8]; float ss = 0.f;
#pragma unroll
      for (int ks = 0; ks < 6; ++ks)
#pragma unroll
          for (int j = 0; j < 4; ++j) { v[ks][2 * j] = bflo(raw[ks][j]); v[ks][2 * j + 1] = bfhi(raw[ks][j]); ss += v[ks][2 * j] * v[ks][2 * j] + v[ks][2 * j + 1] * v[ks][2 * j + 1]; }
      ss += __shfl_xor(ss, 32);
      const float rstd = 1.0f / sqrtf(ss * (1.f / 96.f) + EPS);
#pragma unroll
      for (int ks = 0; ks < 6; ++ks) { const f32x4 g0 = *(const f32x4*)(qhn + 16 * ks + 8 * hi), g1 = *(const f32x4*)(qhn + 16 * ks + 8 * hi + 4);
#pragma unroll
          for (int j = 0; j < 4; ++j) { v[ks][j] *= rstd * g0[j]; v[ks][4 + j] *= rstd * g1[j]; } }
#pragma unroll
      for (int j = 0; j < 8; ++j) { const float cc = j < 4 ? c0[j & 3] : c1[j & 3], sn = j < 4 ? s0[j & 3] : s1[j & 3]; const float t1 = v[4][j], t2 = v[5][j]; v[4][j] = t1 * cc - t2 * sn; v[5][j] = t1 * sn + t2 * cc; }
      const float QSCALE = 0.10206207261596577f * 1.4426950408889634f;
#pragma unroll
      for (int ks = 0; ks < 6; ++ks) { u32x4 w;
#pragma unroll
          for (int j = 0; j < 4; ++j) w[j] = pk2(v[ks][2 * j] * QSCALE, v[ks][2 * j + 1] * QSCALE);
          qf[ks] = __builtin_bit_cast(bf16x8, w); } }
    f32x16 o0, o1, negm;
#pragma unroll
    for (int r = 0; r < 16; ++r) { o0[r] = 0.f; o1[r] = 0.f; negm[r] = 0.f; }
    float m_ref = 0.f, l_run = 0.f;
    const int NT = (q0 + 256) / 64;
    const int kk0 = tid / 12, kp0 = tid % 12, kk1 = (512 + tid) / 12, kp1 = (512 + tid) % 12;
    const bf16* Kg = K + rowbase * QP + h * 96;
    const bf16* Vg = VT + (size_t)(h * 64 + (tid >> 3)) * T + rowbase + (tid & 7) * 8;
    u32x4 kr0A, kr1A = (u32x4){0u, 0u, 0u, 0u}, vrA, kr0B, kr1B = (u32x4){0u, 0u, 0u, 0u}, vrB;
#define ATT_GLOAD(S, t) do { kr0##S = *(const u32x4*)(Kg + (size_t)((t) * 64 + kk0) * QP + kp0 * 8); if (tid < 256) kr1##S = *(const u32x4*)(Kg + (size_t)((t) * 64 + kk1) * QP + kp1 * 8); vr##S = *(const u32x4*)(Vg + (t) * 64); } while (0)
#define ATT_LSTORE(S, buf) do { *(LAS u32x4*)(lds + L_K + (buf) * KBUF + kk0 * KSTR + kp0 * 16) = kr0##S; if (tid < 256) *(LAS u32x4*)(lds + L_K + (buf) * KBUF + kk1 * KSTR + kp1 * 16) = kr1##S; \
        *(LAS u32x4*)(lds + L_V + (buf) * VBUF + (tid >> 3) * VSTR + (tid & 7) * 16) = vr##S; } while (0)
#define ATT_TILE(t, buf) do { const int k0 = (t) * 64; \
        if (k0 <= qw + 31) { \
            const LAS unsigned char* kb = lds + L_K + (buf) * KBUF + r32 * KSTR + hi * 16; \
            f32x16 p0, p1; \
            { const bf16x8 a0 = *(const LAS bf16x8*)(kb), a1 = *(const LAS bf16x8*)(kb + 32 * KSTR); \
              p0 = __builtin_amdgcn_mfma_f32_32x32x16_bf16(a0, qf[0], negm, 0, 0, 0); p1 = __builtin_amdgcn_mfma_f32_32x32x16_bf16(a1, qf[0], negm, 0, 0, 0); } \
            _Pragma("unroll") for (int ks = 1; ks < 6; ++ks) { \
                const bf16x8 a0 = *(const LAS bf16x8*)(kb + ks * 32), a1 = *(const LAS bf16x8*)(kb + 32 * KSTR + ks * 32); \
                p0 = __builtin_amdgcn_mfma_f32_32x32x16_bf16(a0, qf[ks], p0, 0, 0, 0); p1 = __builtin_amdgcn_mfma_f32_32x32x16_bf16(a1, qf[ks], p1, 0, 0, 0); } \
            if (k0 + 63 > qw) { const int q = qw + r32; \
                _Pragma("unroll") for (int r = 0; r < 16; ++r) { const int key = k0 + crow(r, hi); if (key > q) p0[r] = -1e30f; if (key + 32 > q) p1[r] = -1e30f; } } \
            float mxa = __builtin_fmaxf(__builtin_fmaxf(p0[0], p0[1]), p1[0]), mxb = __builtin_fmaxf(__builtin_fmaxf(p0[2], p0[3]), p1[1]); mxa = __builtin_fmaxf(__builtin_fmaxf(mxa, p1[2]), p1[3]); \
            _Pragma("unroll") for (int r = 4; r < 16; r += 4) { mxa = __builtin_fmaxf(__builtin_fmaxf(mxa, p0[r]), p0[r + 1]); mxb = __builtin_fmaxf(__builtin_fmaxf(mxb, p0[r + 2]), p0[r + 3]); \
                mxa = __builtin_fmaxf(__builtin_fmaxf(mxa, p1[r]), p1[r + 1]); mxb = __builtin_fmaxf(__builtin_fmaxf(mxb, p1[r + 2]), p1[r + 3]); } \
            float mx = __builtin_fmaxf(mxa, mxb); mx = __builtin_fmaxf(mx, __shfl_xor(mx, 32)); \
            if (__any(mx > 8.0f)) { const float dl = __builtin_fmaxf(mx, 0.f); m_ref += dl; const float al = __builtin_amdgcn_exp2f(-dl); l_run *= al; \
                _Pragma("unroll") for (int r = 0; r < 16; ++r) { p0[r] -= dl; p1[r] -= dl; o0[r] *= al; o1[r] *= al; negm[r] = -m_ref; } } \
            float rs0 = 0.f, rs1 = 0.f; \
            _Pragma("unroll") for (int r = 0; r < 16; ++r) { p0[r] = __builtin_amdgcn_exp2f(p0[r]); p1[r] = __builtin_amdgcn_exp2f(p1[r]); rs0 += p0[r]; rs1 += p1[r]; } \
            l_run += rs0 + rs1; \
            u32x4 pw[4]; \
            _Pragma("unroll") for (int j = 0; j < 4; ++j) { pw[0][j] = pk2(p0[2 * j], p0[2 * j + 1]); pw[1][j] = pk2(p0[8 + 2 * j], p0[8 + 2 * j + 1]); pw[2][j] = pk2(p1[2 * j], p1[2 * j + 1]); pw[3][j] = pk2(p1[8 + 2 * j], p1[8 + 2 * j + 1]); } \
            const LAS unsigned char* vb = lds + L_V + (buf) * VBUF + r32 * VSTR + hi * 8; \
            _Pragma("unroll") for (int ks = 0; ks < 4; ++ks) { \
                const bf16x8 pf = __builtin_bit_cast(bf16x8, pw[ks]); \
                { const s16x4 lo = *(const LAS s16x4*)(vb + ks * 32), hh = *(const LAS s16x4*)(vb + ks * 32 + 16); \
                  const bf16x8 vf = (bf16x8){lo[0], lo[1], lo[2], lo[3], hh[0], hh[1], hh[2], hh[3]}; \
                  o0 = __builtin_amdgcn_mfma_f32_32x32x16_bf16(vf, pf, o0, 0, 0, 0); } \
                { const s16x4 lo = *(const LAS s16x4*)(vb + 32 * VSTR + ks * 32), hh = *(const LAS s16x4*)(vb + 32 * VSTR + ks * 32 + 16); \
                  const bf16x8 vf = (bf16x8){lo[0], lo[1], lo[2], lo[3], hh[0], hh[1], hh[2], hh[3]}; \
                  o1 = __builtin_amdgcn_mfma_f32_32x32x16_bf16(vf, pf, o1, 0, 0, 0); } } \
        } } while (0)
    ATT_GLOAD(A, 0); ATT_LSTORE(A, 0); ATT_GLOAD(A, 1); ATT_GLOAD(B, 2); __syncthreads();
    for (int t = 0; t < NT; t += 2) {
        ATT_TILE(t, 0);
        ATT_LSTORE(A, 1);
        if (t + 3 < NT) ATT_GLOAD(A, t + 3);
        __syncthreads();
        ATT_TILE(t + 1, 1);
        if (t + 2 < NT) ATT_LSTORE(B, 0);
        if (t + 4 < NT) ATT_GLOAD(B, t + 4);
        __syncthreads();
    }
#undef ATT_GLOAD
#undef ATT_LSTORE
#undef ATT_TILE
    const float l = l_run + __shfl_xor(l_run, 32), inv = 1.0f / l;
    LAS unsigned char* stg = lds + L_OST + wid * (32 * OSTR);
#pragma unroll
    for (int r = 0; r < 16; ++r) { const int d = crow(r, hi);
        *(LAS unsigned short*)(stg + r32 * OSTR + d * 2) = (unsigned short)f2bf(o0[r] * inv);
        *(LAS unsigned short*)(stg + r32 * OSTR + (32 + d) * 2) = (unsigned short)f2bf(o1[r] * inv); }
    LDS_WAIT(); asm volatile("" ::: "memory");
    bf16* Ow = O + (rowbase + qw) * OP + h * 64;
#pragma unroll
    for (int i = 0; i < 4; ++i) { const int row = i * 8 + (lane >> 3), ch = lane & 7; const u32x4 v = *(const LAS u32x4*)(stg + row * OSTR + ch * 16); *(u32x4*)(Ow + (size_t)row * OP + ch * 8) = v; }
    LDS_WAIT(); asm volatile("" ::: "memory");
}
}

constexpr int NPH = 14;
struct Args { const void* in[24]; float* out; unsigned char* ws; int ph_lo, ph_hi; };
static_assert(sizeof(Args) == 24 * 8 + 8 + 8 + 8, "Args has no padding");

__global__ void __launch_bounds__(NWAVES * 64, 2) fwd_kernel(Args args) {
    extern __shared__ __attribute__((aligned(16))) unsigned char lds_raw[];
    LAS unsigned char* lds = (LAS unsigned char*)lds_raw;
    cg::grid_group grid = cg::this_grid();
    const int tid = threadIdx.x, lane = tid & 63, wave = __builtin_amdgcn_readfirstlane(tid >> 6);
    const int G = gridDim.x, bx = blockIdx.x;
    const int gw = bx * NWAVES + wave, NGW = G * NWAVES;
    unsigned char* ws = args.ws;
    const float* x = (const float*)args.in[0]; const int* positions = (const int*)args.in[1];
    float* out = args.out;
    bf16* W1GU = (bf16*)(ws + WS_W1GU); bf16* W1D = (bf16*)(ws + WS_W1D); bf16* WIN = (bf16*)(ws + WS_WIN); bf16* WUQ = (bf16*)(ws + WS_WUQ);
    bf16* WUK = (bf16*)(ws + WS_WUK); bf16* WUV = (bf16*)(ws + WS_WUV); bf16* WPA = (bf16*)(ws + WS_WPA); bf16* WPC = (bf16*)(ws + WS_WPC);
    bf16* WOUT = (bf16*)(ws + WS_WOUT); bf16* W2GU = (bf16*)(ws + WS_W2GU); bf16* W2D = (bf16*)(ws + WS_W2D);
    bf16* XN = (bf16*)(ws + WS_XN); bf16* ZB = (bf16*)(ws + WS_ZB); bf16* HB = (bf16*)(ws + WS_H); bf16* UB = (bf16*)(ws + WS_U); bf16* GBB = (bf16*)(ws + WS_GB);
    bf16* LAT = (bf16*)(ws + WS_LAT); bf16* GATES = (bf16*)(ws + WS_GATES); bf16* QN = (bf16*)(ws + WS_QN); bf16* CKV = (bf16*)(ws + WS_CKV);
    bf16* QB = (bf16*)(ws + WS_Q); bf16* KB = (bf16*)(ws + WS_K); bf16* VT = (bf16*)(ws + WS_VT); bf16* AO = (bf16*)(ws + WS_AO); bf16* MG = (bf16*)(ws + WS_MG); bf16* M1 = (bf16*)(ws + 184 * MiB); float* CS = (float*)(ws + WS_CS);
    const int lo = args.ph_lo, hi = args.ph_hi;
#ifndef PH_MASK
#define PH_MASK 0xFFFF
#endif
#define IN(k) (((PH_MASK >> (k)) & 1) && lo <= (k) && (k) < hi)
    LAS unsigned* misc = (LAS unsigned*)(lds + 131072 + 256);
    if (tid < 64) misc[tid] = 0u;
    __syncthreads();
    XcdBarrier xbar = xcd_barrier_post((unsigned*)ws, (volatile LAS unsigned*)(misc + 8));
    if (hi > NPH) grid.sync();
#define SEAM(k) do { if (IN(k) && IN((k) + 1)) xcd_barrier(xbar); } while (0)

#ifdef NANFILL
    if (lo == 0) {
        for (int i = tid; i < LDS_BYTES / 16; i += 512) *((LAS u32x4*)lds + i) = (u32x4){0x7fc07fc0u, 0x7fc07fc0u, 0x7fc07fc0u, 0x7fc07fc0u};
        __syncthreads();
        u32x4* wsv = (u32x4*)(ws + 120 * MiB);
        for (size_t i = (size_t)bx * 512 + tid; i < (size_t)(376 * MiB / 16); i += (size_t)G * 512) wsv[i] = (u32x4){0x7fc07fc0u, 0x7fc07fc0u, 0x7fc07fc0u, 0x7fc07fc0u};
    }
#endif
#ifndef REPE
#define REPE 1
#endif
    if (IN(0)) for (int repe = 0; repe < REPE; ++repe) {
        LAS float* scr = (LAS float*)(lds + wave * 16384);
        constexpr int I_G = 16 * 88, I_D = 44 * 32, I_IN = 16 * 181, I_UQ = 6 * 24, I_UK = 4 * 16, I_PA = 8 * 32, I_SQ = 16 * 32;
        constexpr int NITEMS = 2 * (2 * I_G + I_D) + I_IN + I_UQ + 2 * I_UK + I_PA + 2 * I_SQ;
        for (int it = gw; it < NITEMS; it += NGW) {
            int r = it;
            if (r < I_G) { p0_transpose_item((const float*)args.in[3], 1024, FF, W1GU, MAP_GATE, scr, r, lane); continue; } r -= I_G;
            if (r < I_G) { p0_transpose_item((const float*)args.in[4], 1024, FF, W1GU, MAP_UP, scr, r, lane); continue; } r -= I_G;
            if (r < I_D) { p0_transpose_item((const float*)args.in[5], FF, 1024, W1D, MAP_ID, scr, r, lane); continue; } r -= I_D;
            if (r < I_G) { p0_transpose_item((const float*)args.in[21], 1024, FF, W2GU, MAP_GATE, scr, r, lane); continue; } r -= I_G;
            if (r < I_G) { p0_transpose_item((const float*)args.in[22], 1024, FF, W2GU, MAP_UP, scr, r, lane); continue; } r -= I_G;
            if (r < I_D) { p0_transpose_item((const float*)args.in[23], FF, 1024, W2D, MAP_ID, scr, r, lane); continue; } r -= I_D;
            if (r < I_IN) { p0_transpose_item((const float*)args.in[7], 1024, NIN, WIN, MAP_WIN, scr, r, lane); continue; } r -= I_IN;
            if (r < I_UQ) { p0_transpose_item((const float*)args.in[10], 384, 768, WUQ, MAP_ID, scr, r, lane); continue; } r -= I_UQ;
            if (r < I_UK) { p0_transpose_item((const float*)args.in[12], 256, 512, WUK, MAP_UK, scr, r, lane); continue; } r -= I_UK;
            if (r < I_UK) { p0_transpose_item((const float*)args.in[13], 256, 512, WUV, MAP_ID, scr, r, lane); continue; } r -= I_UK;
            if (r < I_PA) { p0_transpose_item((const float*)args.in[16], 512, 1024, WPA, MAP_ID, scr, r, lane); continue; } r -= I_PA;
            if (r < I_SQ) { p0_transpose_item((const float*)args.in[18], 1024, 1024, WPC, MAP_ID, scr, r, lane); continue; } r -= I_SQ;
            p0_transpose_item((const float*)args.in[19], 1024, 1024, WOUT, MAP_ID, scr, r, lane);
        }
        for (int i = bx * 512 + tid; i < 12288; i += G * 512) *((u32x4*)(WIN + (size_t)672 * 1024) + i) = (u32x4){0u, 0u, 0u, 0u};
        rms_pass(x, (const float*)args.in[2], XN, gw, NGW, lane);
    }
    SEAM(0);
#ifndef REP1
#define REP1 1
#endif
    if (IN(1)) for (int rep1 = 0; rep1 < REP1; ++rep1) {
        pg8::Gemm g{XN, W1GU, T, 2 * FF, D}; pg8::StaticOrder S; S.init(T, 2 * FF, G, bx);
        pg8::EpiSwiglu E{HB, FF};
        pg8::gemm_phase<pg8::EpiSwiglu, pg8::StaticOrder, true, true>(lds, g, S, E);
    }
    SEAM(1);
    if (IN(2)) {
        pg8::Gemm g{HB, W1D, T, D, FF}; pg8::StaticOrder S; S.init(T, D, G, bx);
        pg8::EpiResF32 E{x, out, D, 0.5f};
        pg8::gemm_phase<pg8::EpiResF32, pg8::StaticOrder, false, true>(lds, g, S, E);
    }
    SEAM(2);
    if (IN(3)) for (int repe = 0; repe < REPE; ++repe) rms_pass(out, (const float*)args.in[6], XN, gw, NGW, lane);
    SEAM(3);
    if (IN(4)) {
        pg8::Gemm g{XN, WIN, T, NINP, D}; pg8::StaticOrder S; S.init(T, NINP, G, bx);
        pg8::EpiWin E{LAT, UB, GBB, GATES, (const float*)args.in[8]};
        pg8::gemm_phase<pg8::EpiWin, pg8::StaticOrder, true, true>(lds, g, S, E);
    }
    SEAM(4);
    if (IN(5)) for (int repe = 0; repe < REPE; ++repe) {
        const float* qg = (const float*)args.in[9]; const float* kg = (const float*)args.in[11]; const float* cw = (const float*)args.in[17];
        f32x4 cwv[2][3][2];
#pragma unroll
        for (int hh = 0; hh < 2; ++hh)
#pragma unroll
            for (int k = 0; k < 3; ++k) { cwv[hh][k][0] = *(const f32x4*)(cw + 1024 * k + 512 * hh + 8 * lane); cwv[hh][k][1] = *(const f32x4*)(cw + 1024 * k + 512 * hh + 8 * lane + 4); }
        for (int m = gw; m < T; m += NGW) {
            const bf16* lr = LAT + (size_t)m * 768;
            u32x4 qv = (u32x4){0u, 0u, 0u, 0u}, kv = (u32x4){0u, 0u, 0u, 0u};
            if (lane < 48) qv = *(const u32x4*)(lr + 8 * lane);
            if (lane < 32) kv = *(const u32x4*)(lr + 384 + 8 * lane);
            float qf[8], kf[8]; float sq = 0.f, sk = 0.f;
#pragma unroll
            for (int j = 0; j < 4; ++j) { qf[2 * j] = bflo(qv[j]); qf[2 * j + 1] = bfhi(qv[j]); kf[2 * j] = bflo(kv[j]); kf[2 * j + 1] = bfhi(kv[j]); }
#pragma unroll
            for (int j = 0; j < 8; ++j) { sq += qf[j] * qf[j]; sk += kf[j] * kf[j]; }
            const float rq = 1.0f / sqrtf(wave_sum(sq) * (1.f / 384.f) + EPS), rk = 1.0f / sqrtf(wave_sum(sk) * (1.f / 256.f) + EPS);
            if (lane < 48) { const f32x4 g0 = *(const f32x4*)(qg + 8 * lane), g1 = *(const f32x4*)(qg + 8 * lane + 4); u32x4 w;
                w.x = pk2(qf[0] * rq * g0.x, qf[1] * rq * g0.y); w.y = pk2(qf[2] * rq * g0.z, qf[3] * rq * g0.w); w.z = pk2(qf[4] * rq * g1.x, qf[5] * rq * g1.y); w.w = pk2(qf[6] * rq * g1.z, qf[7] * rq * g1.w);
                *(u32x4*)(QN + (size_t)m * 384 + 8 * lane) = w; }
            if (lane < 32) { const f32x4 g0 = *(const f32x4*)(kg + 8 * lane), g1 = *(const f32x4*)(kg + 8 * lane + 4); u32x4 w;
                w.x = pk2(kf[0] * rk * g0.x, kf[1] * rk * g0.y); w.y = pk2(kf[2] * rk * g0.z, kf[3] * rk * g0.w); w.z = pk2(kf[4] * rk * g1.x, kf[5] * rk * g1.y); w.w = pk2(kf[6] * rk * g1.z, kf[7] * rk * g1.w);
                *(u32x4*)(CKV + (size_t)m * 256 + 8 * lane) = w; }
            if (lane < 16) { const float invf = __builtin_amdgcn_exp2f(-(float)lane * (13.287712379549449f / 16.0f)); const float ang = (float)positions[m] * invf;
                double rev = (double)ang * 0.15915494309189535; rev -= floor(rev); const float rf = (float)rev;
                CS[(size_t)m * 32 + lane] = __builtin_amdgcn_cosf(rf); CS[(size_t)m * 32 + 16 + lane] = __builtin_amdgcn_sinf(rf); }
            const int tpos = m & (SEQ - 1);
#pragma unroll
            for (int hh = 0; hh < 2; ++hh) {
                const int c = 512 * hh + 8 * lane;
                const u32x4 u0 = *(const u32x4*)(UB + (size_t)m * 1024 + c);
                u32x4 u1 = (u32x4){0u, 0u, 0u, 0u}, u2 = (u32x4){0u, 0u, 0u, 0u};
                if (tpos >= 1) u1 = *(const u32x4*)(UB + (size_t)(m - 1) * 1024 + c);
                if (tpos >= 2) u2 = *(const u32x4*)(UB + (size_t)(m - 2) * 1024 + c);
                const u32x4 gb = *(const u32x4*)(GBB + (size_t)m * 1024 + c);
                u32x4 w;
#pragma unroll
                for (int j = 0; j < 4; ++j) {
                    const int e0 = (2 * j) & 3, e1 = (2 * j + 1) & 3, hv = j >> 1;
                    const float za = cwv[hh][0][hv][e0] * bflo(u2[j]) + cwv[hh][1][hv][e0] * bflo(u1[j]) + cwv[hh][2][hv][e0] * bflo(u0[j]);
                    const float zb = cwv[hh][0][hv][e1] * bfhi(u2[j]) + cwv[hh][1][hv][e1] * bfhi(u1[j]) + cwv[hh][2][hv][e1] * bfhi(u0[j]);
                    w[j] = pk2(bflo(gb[j]) * za, bfhi(gb[j]) * zb);
                }
                *(u32x4*)(ZB + (size_t)m * 1024 + c) = w;
            }
        }
    }
    SEAM(5);
    if (IN(6)) {
#ifndef P6_MASK
#define P6_MASK 7
#endif
        if (P6_MASK & 1) { pg8::Gemm g{QN, WUQ, T, 768, 384}; pg8::StaticOrder S; S.init(T, 768, G, bx); pg8::EpiBf16<false> E{QB, 768};
          pg8::gemm_phase<pg8::EpiBf16<false>, pg8::StaticOrder, true, true>(lds, g, S, E); }
        if (P6_MASK & 2) { pg8::Gemm g{CKV, WUK, T, 512, 256}; pg8::StaticOrder S; S.init(T, 512, G, bx); pg8::EpiKnorm E{KB, LAT, CS, (const float*)args.in[15]};
          pg8::gemm_phase<pg8::EpiKnorm, pg8::StaticOrder, true, true>(lds, g, S, E); }
        if (P6_MASK & 4) { pg8::Gemm g{WUV, CKV, 512, T, 256}; pg8::StaticOrder S; S.init(512, T, G, bx); pg8::EpiBf16<false> E{VT, T};
          pg8::gemm_phase<pg8::EpiBf16<false>, pg8::StaticOrder, true, true>(lds, g, S, E); }
    }
    SEAM(6);
#ifndef REP8
#define REP8 1
#endif
    if (IN(8)) {
        for (int rep8 = 0; rep8 < REP8; ++rep8)
        for (int item = bx; item < 256; item += G) {
            const int v = (item % 8) * 32 + item / 8;
            const int s = v & 3, gq2 = v >> 2;
#pragma unroll 1
            for (int i = 0; i < 4; ++i) {
                const int bh = 2 * gq2 + (i >> 1), qb = (i & 1) ? 7 - s : s;
                att::attn_unit(bh >> 3, bh & 7, qb, QB, KB, VT, AO, (const float*)args.in[14], CS, lds);
            }
        }
    }
    SEAM(8);
    if (IN(9)) {
        { pg8::Gemm g{AO, WPA, T, D, 512}; pg8::StaticOrder S; S.init(T, D, G, bx); pg8::EpiGate<false> E{M1, GATES, 2048, nullptr};
          pg8::gemm_phase<pg8::EpiGate<false>, pg8::StaticOrder, true, true>(lds, g, S, E); }
        { pg8::Gemm g{ZB, WPC, T, D, D}; pg8::StaticOrder S; S.init(T, D, G, bx); pg8::EpiGate<true> E{MG, GATES + 1024, 2048, M1};
          pg8::gemm_phase<pg8::EpiGate<true>, pg8::StaticOrder, true, true>(lds, g, S, E); }
    }
    SEAM(9);
    if (IN(10)) {
        pg8::Gemm g{MG, WOUT, T, D, D}; pg8::StaticOrder S; S.init(T, D, G, bx);
        pg8::EpiResF32 E{out, out, D, 1.0f};
        pg8::gemm_phase<pg8::EpiResF32, pg8::StaticOrder, false, true>(lds, g, S, E);
    }
    SEAM(10);
    if (IN(11)) for (int repe = 0; repe < REPE; ++repe) rms_pass(out, (const float*)args.in[20], XN, gw, NGW, lane);
    SEAM(11);
    if (IN(12)) {
        pg8::Gemm g{XN, W2GU, T, 2 * FF, D}; pg8::StaticOrder S; S.init(T, 2 * FF, G, bx);
        pg8::EpiSwiglu E{HB, FF};
        pg8::gemm_phase<pg8::EpiSwiglu, pg8::StaticOrder, true, true>(lds, g, S, E);
    }
    SEAM(12);
    if (IN(13)) {
        pg8::Gemm g{HB, W2D, T, D, FF}; pg8::StaticOrder S; S.init(T, D, G, bx);
        pg8::EpiResF32 E{out, out, D, 0.5f};
        pg8::gemm_phase<pg8::EpiResF32, pg8::StaticOrder, false, true>(lds, g, S, E);
    }
#ifdef EXTRA_SYNCS
    for (int e = 0; e < EXTRA_SYNCS; ++e) xcd_barrier(xbar);
#endif
#undef IN
#undef SEAM
}


#ifndef DUMP
#define DUMP 0
#endif
#if DUMP
__device__ __forceinline__ float ldbf(const bf16* p) { return __uint_as_float(((unsigned)*p) << 16); }
__global__ void dump_kernel(float* out, unsigned char* ws) {
    const bf16* HB = (const bf16*)(ws + WS_H); const bf16* LAT = (const bf16*)(ws + WS_LAT); const bf16* UB = (const bf16*)(ws + WS_U); const bf16* GBB = (const bf16*)(ws + WS_GB);
    const bf16* GATES = (const bf16*)(ws + WS_GATES); const bf16* ZB = (const bf16*)(ws + WS_ZB); const bf16* QN = (const bf16*)(ws + WS_QN); const bf16* CKV = (const bf16*)(ws + WS_CKV);
    const bf16* QB = (const bf16*)(ws + WS_Q); const bf16* KB = (const bf16*)(ws + WS_K); const bf16* VT = (const bf16*)(ws + WS_VT); const bf16* AO = (const bf16*)(ws + WS_AO); const bf16* MG = (const bf16*)(ws + WS_MG);
    for (size_t i = (size_t)blockIdx.x * blockDim.x + threadIdx.x; i < (size_t)T * D; i += (size_t)gridDim.x * blockDim.x) {
        const size_t m = i / D; const int c = (int)(i % D); float v = 0.f;
        if (DUMP == 1) { v = ldbf(HB + m * FF + c) + ldbf(HB + m * FF + 1024 + c) + (c < 768 ? ldbf(HB + m * FF + 2048 + c) : 0.f); }
        if (DUMP == 4) { v = (c < 672 ? ldbf(LAT + m * 768 + c) : 0.f) + ldbf(UB + m * 1024 + c) + ldbf(GBB + m * 1024 + c) + ldbf(GATES + m * 2048 + c) + ldbf(GATES + m * 2048 + 1024 + c); }
        if (DUMP == 5) { v = ldbf(ZB + m * 1024 + c) + ldbf(QN + m * 384 + c % 384) + ldbf(CKV + m * 256 + c % 256); }
        if (DUMP == 7) { v = ldbf(QB + m * 768 + c % 768) + ldbf(KB + m * 768 + c % 768) + ldbf(VT + (size_t)(c % 512) * T + m); }
        if (DUMP == 8) { v = ldbf(AO + m * 512 + c % 512); }
        if (DUMP == 9) { v = ldbf(MG + m * 1024 + c); }
        out[i] = v;
    }
}
#endif
#ifndef MK_ONE_LAUNCH
#define MK_ONE_LAUNCH 0
#endif
extern "C" void kernel_launch(void* const* d_in, const int* in_sizes, int n_in, void* d_out, int out_size, void* d_ws, size_t ws_size, hipStream_t stream) {
    static int grid = 0;
    if (grid == 0) {
        if (n_in != 24 || in_sizes[0] != T * D || out_size != T * D || ws_size < WS_END) { fprintf(stderr, "kernel_launch: unexpected shapes (n_in %d, in0 %d, out %d, ws %zu)\n", n_in, n_in > 0 ? in_sizes[0] : -1, out_size, ws_size); grid = -1; return; }
        int dev = 0, cus = 0, per_cu = 0;
        if (hipGetDevice(&dev) != hipSuccess || hipDeviceGetAttribute(&cus, hipDeviceAttributeMultiprocessorCount, dev) != hipSuccess) { grid = -1; return; }
        if (hipFuncSetAttribute((const void*)fwd_kernel, hipFuncAttributeMaxDynamicSharedMemorySize, LDS_BYTES) != hipSuccess) { fprintf(stderr, "kernel_launch: hipFuncSetAttribute failed\n"); grid = -1; return; }
        if (hipOccupancyMaxActiveBlocksPerMultiprocessor(&per_cu, (const void*)fwd_kernel, NWAVES * 64, LDS_BYTES) != hipSuccess || per_cu < 1) { fprintf(stderr, "kernel_launch: occupancy query says %d\n", per_cu); per_cu = 1; }
        (void)hipGetLastError();
        grid = cus * 1;
    }
    if (grid < 0) return;
    if (hipMemsetAsync(d_ws, 0, 16384, stream) != hipSuccess) { fprintf(stderr, "kernel_launch: memset of the barrier words failed\n"); return; }
    Args a{};
    for (int i = 0; i < 24; ++i) a.in[i] = d_in[i];
    a.out = (float*)d_out; a.ws = (unsigned char*)d_ws;
#if MK_ONE_LAUNCH
    a.ph_lo = 0; a.ph_hi = NPH;
    void* kargs[] = {&a};
    hipError_t e = hipLaunchCooperativeKernel((const void*)fwd_kernel, dim3(grid), dim3(NWAVES * 64), kargs, LDS_BYTES, stream);
    if (e != hipSuccess) fprintf(stderr, "kernel_launch: cooperative launch failed: %s (grid %d)\n", hipGetErrorString(e), grid);
#else
#ifndef STOP_AFTER
#define STOP_AFTER (NPH - 1)
#endif
    for (int p = 0; p <= STOP_AFTER; ++p) {
        a.ph_lo = p; a.ph_hi = p + 1;
        hipLaunchKernelGGL(fwd_kernel, dim3(grid), dim3(NWAVES * 64), LDS_BYTES, stream, a);
    }
#if DUMP
    if (DUMP != 2 && DUMP != 10) hipLaunchKernelGGL(dump_kernel, dim3(2048), dim3(256), 0, stream, (float*)d_out, (unsigned char*)d_ws);
#endif
#endif
}
```

```cpp
#define MK_ONE_LAUNCH 1
#include <hip/hip_runtime.h>
#include <hip/hip_cooperative_groups.h>
#include <cstdio>
#include <cstdint>
namespace cg = cooperative_groups;
namespace pg8 {
#define PG8_LAS __attribute__((address_space(3)))
typedef unsigned short bf16_t;
typedef short bf16x8 __attribute__((ext_vector_type(8)));
typedef float f32x4 __attribute__((ext_vector_type(4)));
typedef unsigned u32x4 __attribute__((ext_vector_type(4)));
constexpr int BM = 256, BK = 64, HALF = 128, HTB = HALF * BK * 2  , STAGE_BYTES = 8 * HTB, NXCD = 8, WGM = 8;

__host__ __device__ __forceinline__ int lds_byte(int r, int c) { const int st = (r >> 4) * 2 + (c >> 5), rr = r & 15, cc = c & 31, ob = rr * 64 + cc * 2; return st * 1024 + (ob ^ (((ob >> 9) & 1) << 5)); }
__host__ __device__ __forceinline__ void stage_rc(int b, int& R, int& C) { const int st = b / 1024, sb = b % 1024, swz = sb ^ (((sb >> 9) & 1) << 5); R = (st >> 1) * 16 + swz / 64; C = (st & 1) * 32 + (swz % 64) / 2; }
__host__ __device__ __forceinline__ int perm32(int rho) { const int n = rho >> 4, i = rho & 15; return 8 * (i >> 2) + 4 * n + (i & 3); }

struct Unit { int pm, pn; };
struct Gemm { const bf16_t* A; const bf16_t* Bt; int M, N, K; };

struct StaticOrder {
    int nM, nN, nwg, G, c;
    __host__ __device__ void init(int M, int N, int G_, int c_) { nM = M / BM; nN = N / BM; nwg = nM * nN; G = G_; c = c_; }
    __host__ __device__ bool next(int i, Unit& u) const {
        const long L = (long)i * G + c; if (L >= nwg) return false;
        int wgid = (int)L; { const int q = nwg / NXCD, r = nwg % NXCD, xcd = wgid % NXCD, off = wgid / NXCD; wgid = (xcd < r ? xcd * (q + 1) : r * (q + 1) + (xcd - r) * q) + off; }
        const int nig = WGM * nN, gid = wgid / nig, fm = gid * WGM, gsz = (nM - fm) < WGM ? (nM - fm) : WGM;
        u.pm = fm + ((wgid % nig) % gsz); u.pn = (wgid % nig) / gsz; return true;
    }
    __device__ __forceinline__ void a_ready(const Unit&) const {}
    __device__ __forceinline__ void done(const Unit&) const {}
};

typedef float cvt_f32x2 __attribute__((ext_vector_type(2))); typedef __bf16 cvt_bf16x2 __attribute__((ext_vector_type(2)));
__device__ __forceinline__ unsigned cvt_pk_bf16(float lo, float hi) { const cvt_f32x2 v = {lo, hi}; const cvt_bf16x2 b = __builtin_convertvector(v, cvt_bf16x2); return __builtin_bit_cast(unsigned, b); }
typedef float f32x2 __attribute__((ext_vector_type(2)));
__device__ __forceinline__ float fast_sigmoid(float v) { return __builtin_amdgcn_rcpf(1.0f + __builtin_amdgcn_exp2f(-1.4426950408889634f * v)); }
__device__ __forceinline__ u32x4 pack8(const f32x4 v0, const f32x4 v1) { u32x4 w; w.x = cvt_pk_bf16(v0[0], v0[1]); w.y = cvt_pk_bf16(v0[2], v0[3]); w.z = cvt_pk_bf16(v1[0], v1[1]); w.w = cvt_pk_bf16(v1[2], v1[3]); return w; }
__device__ __forceinline__ float bf_lo(unsigned w) { return __uint_as_float(w << 16); }
__device__ __forceinline__ float bf_hi(unsigned w) { return __uint_as_float(w & 0xffff0000u); }
__device__ __forceinline__ void unpack8(const u32x4 w, f32x4& v0, f32x4& v1) { v0 = (f32x4){bf_lo(w.x), bf_hi(w.x), bf_lo(w.y), bf_hi(w.y)}; v1 = (f32x4){bf_lo(w.z), bf_hi(w.z), bf_lo(w.w), bf_hi(w.w)}; }

struct EpiSwiglu {
    static constexpr bool PERM = true, AFTER_DRAIN = false;
    bf16_t* H; int ldh;
    __device__ __forceinline__ void operator()(const f32x4 (&acc)[2][2][4][2], const Unit& u, int wr, int wc, int fr, int fq) const {
        const int row0 = u.pm * BM + wr * 64 + fr, col0 = u.pn * HALF + wc * 32 + 8 * fq;
#pragma unroll
        for (int ai = 0; ai < 2; ++ai)
#pragma unroll
            for (int m = 0; m < 4; ++m) {
                f32x4 h[2];
#pragma unroll
                for (int n = 0; n < 2; ++n) { const f32x4 g = acc[ai][0][m][n], up = acc[ai][1][m][n];
                    const f32x4 t = g * (-1.4426950408889634f); f32x4 e;
#pragma unroll
                    for (int i = 0; i < 4; ++i) e[i] = __builtin_amdgcn_exp2f(t[i]);
                    const f32x4 d = e + 1.0f; f32x4 r;
#pragma unroll
                    for (int i = 0; i < 4; ++i) r[i] = __builtin_amdgcn_rcpf(d[i]);
                    h[n] = (g * up) * r; }
                *(u32x4*)(H + (size_t)(row0 + ai * HALF + m * 16) * ldh + col0) = pack8(h[0], h[1]);
            }
    }
};
struct EpiResF32 {
    static constexpr bool PERM = false, AFTER_DRAIN = false;
    const float* base; float* out; int ldc; float scale;
    __device__ __forceinline__ void operator()(const f32x4 (&acc)[2][2][4][2], const Unit& u, int wr, int wc, int fr, int fq) const {
        const int row0 = u.pm * BM + wr * 64 + fr, col0 = u.pn * BM + wc * 32 + 4 * fq;
#pragma unroll
        for (int ai = 0; ai < 2; ++ai)
#pragma unroll
            for (int m = 0; m < 4; ++m) { const size_t off = (size_t)(row0 + ai * HALF + m * 16) * ldc + col0;
#pragma unroll
                for (int bj = 0; bj < 2; ++bj)
#pragma unroll
                    for (int n = 0; n < 2; ++n) { const f32x4 b = *(const f32x4*)(base + off + bj * HALF + n * 16); *(f32x4*)(out + off + bj * HALF + n * 16) = b + acc[ai][bj][m][n] * scale; }
                if (m & 1) asm volatile("" ::: "memory"); }
    }
};
template <bool REMAP> struct EpiBf16 {
    static constexpr bool PERM = true, AFTER_DRAIN = false;
    bf16_t* O; int ldc;
    __device__ __forceinline__ void operator()(const f32x4 (&acc)[2][2][4][2], const Unit& u, int wr, int wc, int fr, int fq) const {
        const int row0 = u.pm * BM + wr * 64 + fr, c0 = u.pn * BM + wc * 32 + 8 * fq;
#pragma unroll
        for (int ai = 0; ai < 2; ++ai)
#pragma unroll
            for (int m = 0; m < 4; ++m) { bf16_t* rowp = O + (size_t)(row0 + ai * HALF + m * 16) * ldc;
#pragma unroll
                for (int bj = 0; bj < 2; ++bj) { const int c = c0 + bj * HALF; const int dc = REMAP ? ((c >> 6) * 96 + (c & 63)) : c;
                    *(u32x4*)(rowp + dc) = pack8(acc[ai][bj][m][0], acc[ai][bj][m][1]); } }
    }
};
struct EpiWin {
    static constexpr bool PERM = true, AFTER_DRAIN = false;
    bf16_t *LAT, *U, *GB, *GATES; const float* gate_bias;
    __device__ __forceinline__ void operator()(const f32x4 (&acc)[2][2][4][2], const Unit& u, int wr, int wc, int fr, int fq) const {
        const int row0 = u.pm * BM + wr * 64 + fr, cw = wc * 32 + 8 * fq; const int pn = u.pn;
        if (pn >= 3 && pn < 11) {
#pragma unroll
            for (int ai = 0; ai < 2; ++ai)
#pragma unroll
                for (int m = 0; m < 4; ++m)
                    *(u32x4*)(U + (size_t)(row0 + ai * HALF + m * 16) * 1024 + (pn - 3) * HALF + cw) = pack8(acc[ai][0][m][0] * acc[ai][1][m][0], acc[ai][0][m][1] * acc[ai][1][m][1]);
        } else if (pn >= 15) {
            f32x4 bv[2][2];
#pragma unroll
            for (int bj = 0; bj < 2; ++bj)
#pragma unroll
                for (int n = 0; n < 2; ++n) bv[bj][n] = *(const f32x4*)(gate_bias + (pn - 15) * BM + bj * HALF + cw + 4 * n);
#pragma unroll
            for (int ai = 0; ai < 2; ++ai)
#pragma unroll
                for (int m = 0; m < 4; ++m)
#pragma unroll
                    for (int bj = 0; bj < 2; ++bj) { f32x4 s[2];
#pragma unroll
                        for (int n = 0; n < 2; ++n) { const f32x4 v = acc[ai][bj][m][n] + bv[bj][n];
#pragma unroll
                            for (int i = 0; i < 4; ++i) s[n][i] = fast_sigmoid(v[i]); }
                        *(u32x4*)(GATES + (size_t)(row0 + ai * HALF + m * 16) * 2048 + (pn - 15) * BM + bj * HALF + cw) = pack8(s[0], s[1]); }
        } else {
            bf16_t* O = pn < 3 ? LAT : GB; const int ldc = pn < 3 ? 768 : 1024; const int ct = pn < 3 ? pn * BM : (pn - 11) * BM;
#pragma unroll
            for (int ai = 0; ai < 2; ++ai)
#pragma unroll
                for (int m = 0; m < 4; ++m)
#pragma unroll
                    for (int bj = 0; bj < 2; ++bj)
                        *(u32x4*)(O + (size_t)(row0 + ai * HALF + m * 16) * ldc + ct + bj * HALF + cw) = pack8(acc[ai][bj][m][0], acc[ai][bj][m][1]);
        }
    }
};
template <bool ADD> struct EpiGate {
    static constexpr bool PERM = true, AFTER_DRAIN = false;
    bf16_t* Mg; const bf16_t* G; int ldg; const bf16_t* Prev;
    __device__ __forceinline__ void operator()(const f32x4 (&acc)[2][2][4][2], const Unit& u, int wr, int wc, int fr, int fq) const {
        const int row0 = u.pm * BM + wr * 64 + fr, c0 = u.pn * BM + wc * 32 + 8 * fq;
#pragma unroll
        for (int ai = 0; ai < 2; ++ai)
#pragma unroll
            for (int m = 0; m < 4; ++m) { const size_t r = (size_t)(row0 + ai * HALF + m * 16);
#pragma unroll
                for (int bj = 0; bj < 2; ++bj) { const int c = c0 + bj * HALF;
                    f32x4 g0, g1; unpack8(*(const u32x4*)(G + r * ldg + c), g0, g1);
                    f32x4 v0 = g0 * acc[ai][bj][m][0], v1 = g1 * acc[ai][bj][m][1];
                    if (ADD) { f32x4 p0, p1; unpack8(*(const u32x4*)(Prev + r * 1024 + c), p0, p1); v0 += p0; v1 += p1; }
                    *(u32x4*)(Mg + r * 1024 + c) = pack8(v0, v1); } }
    }
};

struct EpiKnorm {
    static constexpr bool PERM = true, AFTER_DRAIN = false;
    bf16_t* K; const bf16_t* LAT; const float* CS; const float* gk;
    __device__ __forceinline__ void operator()(const f32x4 (&acc)[2][2][4][2], const Unit& u, int wr, int wc, int fr, int fq) const {
        typedef unsigned u32x2e __attribute__((ext_vector_type(2)));
        const int head = u.pn * 4 + wc, row0 = u.pm * BM + wr * 64 + fr;
        f32x4 gn[2][2];
#pragma unroll
        for (int bj = 0; bj < 2; ++bj)
#pragma unroll
            for (int n = 0; n < 2; ++n) gn[bj][n] = *(const f32x4*)(gk + 32 * bj + 8 * fq + 4 * n);
        const f32x4 g1 = *(const f32x4*)(gk + 64 + 4 * fq), g2 = *(const f32x4*)(gk + 80 + 4 * fq);
#pragma unroll
        for (int ai = 0; ai < 2; ++ai)
#pragma unroll
            for (int m = 0; m < 4; ++m) {
                const size_t row = (size_t)(row0 + ai * HALF + m * 16);
                const u32x2e w1 = *(const u32x2e*)(LAT + row * 768 + 640 + 4 * fq), w2 = *(const u32x2e*)(LAT + row * 768 + 656 + 4 * fq);
                f32x4 t1 = (f32x4){bf_lo(w1.x), bf_hi(w1.x), bf_lo(w1.y), bf_hi(w1.y)}, t2 = (f32x4){bf_lo(w2.x), bf_hi(w2.x), bf_lo(w2.y), bf_hi(w2.y)};
                const f32x4 cs = *(const f32x4*)(CS + row * 32 + 4 * fq), sn = *(const f32x4*)(CS + row * 32 + 16 + 4 * fq);
                float ss = (t1[0] * t1[0] + t1[1] * t1[1]) + (t1[2] * t1[2] + t1[3] * t1[3]) + (t2[0] * t2[0] + t2[1] * t2[1]) + (t2[2] * t2[2] + t2[3] * t2[3]);
#pragma unroll
                for (int bj = 0; bj < 2; ++bj)
#pragma unroll
                    for (int n = 0; n < 2; ++n) { const f32x4 a = acc[ai][bj][m][n]; ss += (a[0] * a[0] + a[1] * a[1]) + (a[2] * a[2] + a[3] * a[3]); }
                ss += __shfl_xor(ss, 16); ss += __shfl_xor(ss, 32);
                const float rstd = 1.0f / sqrtf(ss * (1.0f / 96.0f) + 1e-6f);
                bf16_t* kr = K + row * 768 + 96 * head;
#pragma unroll
                for (int bj = 0; bj < 2; ++bj)
                    *(u32x4*)(kr + 32 * bj + 8 * fq) = pack8(acc[ai][bj][m][0] * rstd * gn[bj][0], acc[ai][bj][m][1] * rstd * gn[bj][1]);
                t1 = t1 * rstd * g1; t2 = t2 * rstd * g2;
                const f32x4 o1 = t1 * cs - t2 * sn, o2 = t1 * sn + t2 * cs;
                u32x2e p1, p2; p1.x = cvt_pk_bf16(o1[0], o1[1]); p1.y = cvt_pk_bf16(o1[2], o1[3]); p2.x = cvt_pk_bf16(o2[0], o2[1]); p2.y = cvt_pk_bf16(o2[2], o2[3]);
                *(u32x2e*)(kr + 64 + 4 * fq) = p1; *(u32x2e*)(kr + 80 + 4 * fq) = p2;
            }
    }
};
template <class Epi, class Sched, bool ALIGN_EPI = false, bool SP2 = false>
__device__ __forceinline__ void gemm_phase(PG8_LAS unsigned char* lds, const Gemm g, const Sched& S, const Epi& E) {
    const int tid = threadIdx.x, wid = __builtin_amdgcn_readfirstlane(tid >> 6), lane = tid & 63, wr = wid >> 2, wc = wid & 3, fr = lane & 15, fq = lane >> 4;
    const int K = g.K, nt = K / BK;
    unsigned voffA[2], voffB[2];
#pragma unroll
    for (int i = 0; i < 2; ++i) { int R, C; stage_rc(tid * 16 + i * 8192, R, C); const int Rb = Epi::PERM ? ((R & ~31) + perm32(R & 31)) : R;
        voffA[i] = (unsigned)(R * K + C) * 2u; voffB[i] = (unsigned)(Rb * K + C) * 2u; }
    const size_t kstep = (size_t)(BK * 2);
    const size_t hstep = (size_t)HALF * K * 2;
    const size_t tstep = 2 * hstep;
    const unsigned ldsw = (unsigned)wid * 1024u;
    const int aoff = lds_byte(wr * 64 + fr, fq * 8), boff = lds_byte(wc * 32 + fr, fq * 8);
#define PG8_SA(b, h) (((b) * 2 + (h)) * HTB)
#define PG8_SB(b, h) ((4 + (b) * 2 + (h)) * HTB)
#define PG8_STAGE(bufoff, gbase, voff) do { _Pragma("unroll") for (int _i = 0; _i < 2; ++_i) \
        __builtin_amdgcn_global_load_lds((const unsigned*)((const char*)(gbase) + (voff)[_i]), (PG8_LAS unsigned*)(lds + (bufoff) + ldsw + _i * 8192), 16, 0, 0); } while (0)
#define PG8_LDA(dst, b, h) do { _Pragma("unroll") for (int m = 0; m < 4; ++m) _Pragma("unroll") for (int k = 0; k < 2; ++k) dst[m][k] = *(const PG8_LAS bf16x8*)(lds + PG8_SA(b, h) + aoff + m * 2048 + k * 1024); } while (0)
#define PG8_LDB(dst, b, h) do { _Pragma("unroll") for (int n = 0; n < 2; ++n) _Pragma("unroll") for (int k = 0; k < 2; ++k) dst[n][k] = *(const PG8_LAS bf16x8*)(lds + PG8_SB(b, h) + boff + n * 2048 + k * 1024); } while (0)
#define PG8_MMA(ai, bj, At, Bt) do { __builtin_amdgcn_s_setprio(1); _Pragma("unroll") for (int m = 0; m < 4; ++m) _Pragma("unroll") for (int n = 0; n < 2; ++n) _Pragma("unroll") for (int k = 0; k < 2; ++k) \
        acc[ai][bj][m][n] = __builtin_amdgcn_mfma_f32_16x16x32_bf16(Bt[n][k], At[m][k], acc[ai][bj][m][n], 0, 0, 0); __builtin_amdgcn_s_setprio(0); } while (0)
#define PG8_WAIT_V(n) asm volatile("s_waitcnt vmcnt(" #n ")" ::: "memory")
#define PG8_WAIT_L(n) asm volatile("s_waitcnt lgkmcnt(" #n ")" ::: "memory")
#define PG8_BAR __builtin_amdgcn_s_barrier()
#define PG8_SCHED __builtin_amdgcn_sched_barrier(0)
    Unit cur, nxt; int ui = 0;
    if (!S.next(0, cur)) return;
    f32x4 acc[2][2][4][2];
#pragma unroll
    for (int a = 0; a < 2; ++a)
#pragma unroll
        for (int b = 0; b < 2; ++b)
#pragma unroll
            for (int m = 0; m < 4; ++m)
#pragma unroll
                for (int n = 0; n < 2; ++n) acc[a][b][m][n] = (f32x4){0.f, 0.f, 0.f, 0.f};
    bf16x8 At[4][2], B0[2][2], B1[2][2];
    const char* cA = (const char*)g.A + (size_t)cur.pm * tstep; const char* cB = (const char*)g.Bt + (size_t)cur.pn * tstep;
    S.a_ready(cur);
    if constexpr (SP2) {
        PG8_STAGE(PG8_SB(0, 0), cB, voffB); PG8_STAGE(PG8_SB(0, 1), cB + hstep, voffB); PG8_STAGE(PG8_SA(0, 0), cA, voffA); PG8_STAGE(PG8_SA(0, 1), cA + hstep, voffA);
        if (wr == 1) PG8_BAR;
        PG8_WAIT_V(2); PG8_BAR;
        PG8_STAGE(PG8_SB(1, 0), cB + kstep, voffB); PG8_STAGE(PG8_SA(1, 0), cA + kstep, voffA); PG8_STAGE(PG8_SB(1, 1), cB + hstep + kstep, voffB);
        PG8_WAIT_V(6); PG8_BAR;
    } else {
        PG8_STAGE(PG8_SB(0, 0), cB, voffB); PG8_STAGE(PG8_SA(0, 0), cA, voffA); PG8_STAGE(PG8_SB(0, 1), cB + hstep, voffB); PG8_STAGE(PG8_SA(0, 1), cA + hstep, voffA);
        if (wr == 1) PG8_BAR;
        PG8_WAIT_V(4); PG8_BAR;
        PG8_STAGE(PG8_SB(1, 0), cB + kstep, voffB); PG8_STAGE(PG8_SA(1, 0), cA + kstep, voffA); PG8_STAGE(PG8_SB(1, 1), cB + hstep + kstep, voffB);
        PG8_WAIT_V(6); PG8_BAR;
    }
    for (;;) {
        const bool has_next = S.next(ui + 1, nxt);
        const char* nA = has_next ? (const char*)g.A + (size_t)nxt.pm * tstep : cA; const char* nB = has_next ? (const char*)g.Bt + (size_t)nxt.pn * tstep : cB;
_Pragma("unroll 1")
        for (int t = 0; t < nt; t += 2) {
            const bool last = (t == nt - 2);
            const char* a1 = cA + (size_t)(t + 1) * kstep;
            const char* a2 = last ? nA : cA + (size_t)(t + 2) * kstep; const char* b2 = last ? nB : cB + (size_t)(t + 2) * kstep;
            const char* a3 = a2 + kstep; const char* b3 = b2 + kstep;
            if (last && has_next) S.a_ready(nxt);
            if constexpr (SP2) {
            PG8_LDB(B0, 0, 0); PG8_LDB(B1, 0, 1); PG8_SCHED; PG8_LDA(At, 0, 0); PG8_STAGE(PG8_SA(1, 1), a1 + hstep, voffA);
            PG8_WAIT_V(8); PG8_WAIT_L(0); PG8_BAR; PG8_MMA(0, 0, At, B0); PG8_MMA(0, 1, At, B1); PG8_BAR; PG8_SCHED;
            PG8_LDA(At, 0, 1); PG8_STAGE(PG8_SB(0, 0), b2, voffB); PG8_STAGE(PG8_SB(0, 1), b2 + hstep, voffB); PG8_STAGE(PG8_SA(0, 0), a2, voffA);
            PG8_WAIT_V(8); PG8_WAIT_L(0); PG8_BAR; PG8_MMA(1, 0, At, B0); PG8_MMA(1, 1, At, B1); PG8_BAR; PG8_SCHED;
            PG8_LDB(B0, 1, 0); PG8_LDB(B1, 1, 1); PG8_SCHED; PG8_LDA(At, 1, 0); PG8_STAGE(PG8_SA(0, 1), a2 + hstep, voffA);
            PG8_WAIT_V(8); PG8_WAIT_L(0); PG8_BAR; PG8_MMA(0, 0, At, B0); PG8_MMA(0, 1, At, B1); PG8_BAR; PG8_SCHED;
            PG8_LDA(At, 1, 1); PG8_STAGE(PG8_SB(1, 0), b3, voffB); PG8_STAGE(PG8_SB(1, 1), b3 + hstep, voffB); PG8_STAGE(PG8_SA(1, 0), a3, voffA);
            PG8_WAIT_V(8); PG8_WAIT_L(0); PG8_BAR; PG8_MMA(1, 0, At, B0); PG8_MMA(1, 1, At, B1); PG8_BAR; PG8_SCHED;
            } else {
            PG8_LDB(B0, 0, 0); PG8_SCHED; PG8_LDA(At, 0, 0); PG8_STAGE(PG8_SA(1, 1), a1 + hstep, voffA);
            PG8_WAIT_L(8); PG8_BAR; PG8_WAIT_L(0); PG8_MMA(0, 0, At, B0); PG8_BAR; PG8_SCHED;
            PG8_LDB(B1, 0, 1); PG8_STAGE(PG8_SB(0, 0), b2, voffB);
            PG8_BAR; PG8_WAIT_L(0); PG8_MMA(0, 1, At, B1); PG8_BAR;
            PG8_LDA(At, 0, 1); PG8_STAGE(PG8_SA(0, 0), a2, voffA);
            PG8_BAR; PG8_WAIT_L(0); PG8_MMA(1, 0, At, B0); PG8_BAR; PG8_SCHED;
            PG8_STAGE(PG8_SB(0, 1), b2 + hstep, voffB);
            PG8_WAIT_V(6); PG8_BAR; PG8_MMA(1, 1, At, B1); PG8_BAR;
            PG8_LDB(B0, 1, 0); PG8_SCHED; PG8_LDA(At, 1, 0); PG8_STAGE(PG8_SA(0, 1), a2 + hstep, voffA);
            PG8_WAIT_L(8); PG8_BAR; PG8_WAIT_L(0); PG8_MMA(0, 0, At, B0); PG8_BAR; PG8_SCHED;
            PG8_LDB(B1, 1, 1); PG8_STAGE(PG8_SB(1, 0), b3, voffB);
            PG8_BAR; PG8_WAIT_L(0); PG8_MMA(0, 1, At, B1); PG8_BAR;
            PG8_LDA(At, 1, 1); PG8_STAGE(PG8_SA(1, 0), a3, voffA);
            PG8_BAR; PG8_WAIT_L(0); PG8_MMA(1, 0, At, B0); PG8_BAR; PG8_SCHED;
            PG8_STAGE(PG8_SB(1, 1), b3 + hstep, voffB);
            PG8_WAIT_V(6); PG8_BAR; PG8_MMA(1, 1, At, B1); PG8_BAR;
            }
        }
        if constexpr (ALIGN_EPI) { if (wr == 0) PG8_BAR; }
        if constexpr (!Epi::AFTER_DRAIN) { E(acc, cur, wr, wc, fr, fq); S.done(cur); }
        if (!has_next) break;
#pragma unroll
        for (int a = 0; a < 2; ++a)
#pragma unroll
            for (int b = 0; b < 2; ++b)
#pragma unroll
                for (int m = 0; m < 4; ++m)
#pragma unroll
                    for (int n = 0; n < 2; ++n) acc[a][b][m][n] = (f32x4){0.f, 0.f, 0.f, 0.f};
        cur = nxt; cA = nA; cB = nB; ++ui;
        if constexpr (ALIGN_EPI) { if (wr == 1) PG8_BAR; }
    }
    PG8_WAIT_V(0);
    if constexpr (!ALIGN_EPI) { if (wr == 0) PG8_BAR; }
    PG8_BAR;
    if constexpr (Epi::AFTER_DRAIN) { E.fused(acc, cur, wr, wc, fr, fq, lds, wid, lane); S.done(cur); }
#undef PG8_SA
#undef PG8_SB
#undef PG8_STAGE
#undef PG8_LDA
#undef PG8_LDB
#undef PG8_MMA
#undef PG8_WAIT_V
#undef PG8_WAIT_L
#undef PG8_BAR
#undef PG8_SCHED
}
}

#define LAS __attribute__((address_space(3)))
typedef unsigned short bf16;
typedef unsigned u32x4 __attribute__((ext_vector_type(4)));
typedef unsigned u32x2 __attribute__((ext_vector_type(2)));
typedef float f32x4 __attribute__((ext_vector_type(4)));
typedef float f32x16 __attribute__((ext_vector_type(16)));
typedef short bf16x8 __attribute__((ext_vector_type(8)));
typedef short s16x4 __attribute__((ext_vector_type(4)));
constexpr int NWAVES = 8;
typedef unsigned short bf16_fwd_unused;
#define XB_TMO      128
#define XB_XCNT(j)  (256  + 64 * (j))
#define XB_XSUB(j)  (1280 + 64 * (j))
#define XB_XGEN(j)  (2304 + 64 * (j))
#define XB_TOP      3328
#define XB_TOPGEN   3392
#define XCD_BAR_WORDS 3456
#define XB_SPIN_CAP (1u << 18)

__device__ __forceinline__ unsigned xb_ld(unsigned* p)              { return __hip_atomic_load(p, __ATOMIC_RELAXED, __HIP_MEMORY_SCOPE_AGENT); }
__device__ __forceinline__ unsigned xb_add(unsigned* p, unsigned v) { return __hip_atomic_fetch_add(p, v, __ATOMIC_RELAXED, __HIP_MEMORY_SCOPE_AGENT); }
__device__ __forceinline__ unsigned xb_xcc_id() { return (unsigned)__builtin_amdgcn_s_getreg((3 << 11) | 20) & 0xFu; }
#define XB_SPIN(cond, bar) do { unsigned _sp = 0; while (cond) { __builtin_amdgcn_s_sleep(1); \
    if ((++_sp & 255u) == 0u) { if (xb_ld(&(bar)[XB_TMO])) break; if (_sp > XB_SPIN_CAP) { atomicAdd(&(bar)[XB_TMO], 1u); break; } } } } while (0)

struct XcdBarrier {
    unsigned* bar; unsigned x;
    volatile LAS unsigned* st;
};

__device__ __forceinline__ XcdBarrier xcd_barrier_post(unsigned* bar, volatile LAS unsigned* st) {
    XcdBarrier b; b.bar = bar; b.x = xb_xcc_id(); b.st = st;
    if (threadIdx.x == 0) (void)xb_add(&bar[XB_XCNT(b.x)], 1u);
    return b;
}
__device__ __forceinline__ void xcd_barrier_complete(unsigned* bar, unsigned x, unsigned& nloc, unsigned& nx) {
    const unsigned G = gridDim.x * gridDim.y * gridDim.z;
    unsigned sum, cnt, mine, sp = 0u;
    for (;;) {
        sum = 0u; cnt = 0u; mine = 0u;
#pragma unroll
        for (unsigned j = 0; j < 16; ++j) { const unsigned c = xb_ld(&bar[XB_XCNT(j)]); sum += c; cnt += (c > 0u) ? 1u : 0u; mine = (j == x) ? c : mine; }
        if (sum == G) break;
        __builtin_amdgcn_s_sleep(1);
        if ((++sp & 255u) == 0u) { if (xb_ld(&bar[XB_TMO])) break; if (sp > XB_SPIN_CAP) { atomicAdd(&bar[XB_TMO], 1u); break; } }
    }
    nloc = mine > 0u ? mine : 1u; nx = cnt > 0u ? cnt : 1u;
}

__device__ __forceinline__ void xcd_barrier(const XcdBarrier& b) {
    asm volatile("s_waitcnt vmcnt(0)" ::: "memory");
    __syncthreads();
    if (threadIdx.x == 0) {
        unsigned* bar = b.bar;
        __builtin_amdgcn_s_waitcnt(0);
        unsigned nloc = b.st[0], nx = b.st[1];
        if (nloc == 0u) { xcd_barrier_complete(bar, b.x, nloc, nx); b.st[0] = nloc; b.st[1] = nx; }
        const unsigned old = xb_add(&bar[XB_XSUB(b.x)], 1u);
        const unsigned gen = old / nloc;
        if (old + 1u == (gen + 1u) * nloc) {
            __builtin_amdgcn_fence(__ATOMIC_RELEASE, "agent");
            asm volatile("s_waitcnt vmcnt(0)" ::: "memory");
            const unsigned og = xb_add(&bar[XB_TOP], 1u);
            const unsigned tg = og / nx;
            if (og + 1u == (tg + 1u) * nx) xb_add(&bar[XB_TOPGEN], 1u);
            else XB_SPIN(xb_ld(&bar[XB_TOPGEN]) == tg, bar);
            __builtin_amdgcn_fence(__ATOMIC_ACQUIRE, "agent");
            xb_add(&bar[XB_XGEN(b.x)], 1u);
            asm volatile("s_waitcnt vmcnt(0)" ::: "memory");
        } else {
            XB_SPIN(xb_ld(&bar[XB_XGEN(b.x)]) == gen, bar);
            __builtin_amdgcn_fence(__ATOMIC_ACQUIRE, "agent");
            asm volatile("s_waitcnt vmcnt(0)" ::: "memory");
        }
    }
    __syncthreads();
}

constexpr int T = 32768, D = 1024, FF = 2816, SEQ = 2048, NH = 8;
constexpr int NIN = 5792, NINP = 5888;
constexpr float EPS = 1e-6f;
constexpr size_t MiB = 1u << 20;
constexpr size_t WS_W1GU = 1 * MiB;
constexpr size_t WS_W1D = WS_W1GU + 11 * MiB;
constexpr size_t WS_WIN = WS_W1D + 6 * MiB;
constexpr size_t WS_WUQ = WS_WIN + 12 * MiB;
constexpr size_t WS_WUK = WS_WUQ + 1 * MiB;
constexpr size_t WS_WUV = WS_WUK + 1 * MiB;
constexpr size_t WS_WPA = WS_WUV + 1 * MiB;
constexpr size_t WS_WPC = WS_WPA + 1 * MiB;
constexpr size_t WS_WOUT = WS_WPC + 2 * MiB;
constexpr size_t WS_W2GU = WS_WOUT + 2 * MiB;
constexpr size_t WS_W2D = WS_W2GU + 11 * MiB;
static_assert(WS_W2D + 6 * MiB <= 56 * MiB, "weights");
constexpr size_t WS_XN = 56 * MiB;
constexpr size_t WS_ZB = WS_XN;
constexpr size_t WS_H = 120 * MiB;
constexpr size_t WS_U = 120 * MiB, WS_GB = 184 * MiB, WS_LAT = 248 * MiB;
constexpr size_t WS_GATES = 296 * MiB;
constexpr size_t WS_QN = 424 * MiB, WS_CKV = 448 * MiB;
constexpr size_t WS_Q = 120 * MiB, WS_K = 168 * MiB, WS_VT = 216 * MiB;
constexpr size_t WS_AO = 464 * MiB;
constexpr size_t WS_MG = 120 * MiB;
constexpr size_t WS_CS = 496 * MiB;
constexpr size_t WS_END = 500 * MiB;
constexpr int LDS_BYTES = 147456;

__device__ __forceinline__ unsigned f2bf(float f) { unsigned u = __builtin_bit_cast(unsigned, f); return (u + 0x7fffu + ((u >> 16) & 1u)) >> 16; }
__device__ __forceinline__ unsigned pk2(float lo, float hi) { return pg8::cvt_pk_bf16(lo, hi); }
__device__ __forceinline__ float bflo(unsigned w) { return __uint_as_float(w << 16); }
__device__ __forceinline__ float bfhi(unsigned w) { return __uint_as_float(w & 0xffff0000u); }
__device__ __forceinline__ float wave_sum(float v) {
#pragma unroll
    for (int o = 1; o < 64; o <<= 1) v += __shfl_xor(v, o);
    return v;
}
#define LDS_WAIT() asm volatile("s_waitcnt lgkmcnt(0)" ::: "memory")

enum { MAP_ID = 0, MAP_GATE = 1, MAP_UP = 2, MAP_WIN = 3, MAP_UK = 4 };
__device__ __forceinline__ int map_row(int mode, int n0) {
    if (mode == MAP_GATE) return 256 * (n0 >> 7) + (n0 & 127);
    if (mode == MAP_UP) return 256 * (n0 >> 7) + 128 + (n0 & 127);
    if (mode == MAP_UK) { const int head = n0 >> 6, dim = n0 & 63; return 256 * (head >> 2) + 128 * (dim >> 5) + 32 * (head & 3) + (dim & 31); }
    if (mode == MAP_WIN) {
        if (n0 < 672) return n0;
        if (n0 < 1696) { const int j = n0 - 672; return 256 * (3 + (j >> 7)) + (j & 127); }
        if (n0 < 2720) { return 256 * 11 + (n0 - 1696); }
        if (n0 < 3744) { const int j = n0 - 2720; return 256 * (3 + (j >> 7)) + 128 + (j & 127); }
        return 256 * 15 + (n0 - 3744);
    }
    return n0;
}
__device__ __forceinline__ void p0_transpose_item(const float* W, int K, int N, bf16* WT, int mode, LAS float* scr, int item, int lane) {
    const int nblk = N / 32, kb = item / nblk, nb = item % nblk, k0 = 64 * kb, n0 = 32 * nb;
    const int r0 = map_row(mode, n0);
    float wv[32];
    { const float* wp = W + (size_t)(k0 + (lane >> 5)) * N + n0 + (lane & 31);
#pragma unroll
      for (int i = 0; i < 32; ++i) wv[i] = wp[(size_t)(2 * i) * N]; }
#pragma unroll
    for (int i = 0; i < 32; ++i) scr[(2 * i + (lane >> 5)) * 33 + (lane & 31)] = wv[i];
    LDS_WAIT(); asm volatile("" ::: "memory");
    const int c = lane & 7;
#pragma unroll
    for (int j = 0; j < 4; ++j) { const int n = (lane >> 3) + 8 * j; const LAS float* s = scr + (8 * c) * 33 + n;
        u32x4 o; o.x = pk2(s[0 * 33], s[1 * 33]); o.y = pk2(s[2 * 33], s[3 * 33]); o.z = pk2(s[4 * 33], s[5 * 33]); o.w = pk2(s[6 * 33], s[7 * 33]);
        *(u32x4*)(WT + (size_t)(r0 + n) * K + k0 + 8 * c) = o; }
    LDS_WAIT(); asm volatile("" ::: "memory");
}
__device__ __forceinline__ void rms_row_to_bf16(const float* xrow, const float* gain, bf16* orow, int lane) {
    const f32x4* xr = (const f32x4*)xrow + lane; const f32x4* gr = (const f32x4*)gain + lane;
    f32x4 v[4]; float s = 0.f;
#pragma unroll
    for (int j = 0; j < 4; ++j) { v[j] = xr[64 * j]; s += (v[j].x * v[j].x + v[j].y * v[j].y) + (v[j].z * v[j].z + v[j].w * v[j].w); }
    const float rstd = 1.0f / sqrtf(wave_sum(s) * (1.f / 1024.f) + EPS);
    u32x2* o8 = (u32x2*)orow + lane;
#pragma unroll
    for (int j = 0; j < 4; ++j) { const f32x4 g = gr[64 * j]; u32x2 w; w.x = pk2(v[j].x * rstd * g.x, v[j].y * rstd * g.y); w.y = pk2(v[j].z * rstd * g.z, v[j].w * rstd * g.w); o8[64 * j] = w; }
}

__device__ __forceinline__ void rms_rows2_to_bf16(const float* xa, const float* xb, const float* gain, bf16* oa, bf16* ob, int lane) {
    const f32x4* xr0 = (const f32x4*)xa + lane; const f32x4* xr1 = (const f32x4*)xb + lane; const f32x4* gr = (const f32x4*)gain + lane;
    f32x4 v0[4], v1[4]; float s0 = 0.f, s1 = 0.f;
#pragma unroll
    for (int j = 0; j < 4; ++j) { v0[j] = xr0[64 * j]; v1[j] = xr1[64 * j]; }
#pragma unroll
    for (int j = 0; j < 4; ++j) { s0 += (v0[j].x * v0[j].x + v0[j].y * v0[j].y) + (v0[j].z * v0[j].z + v0[j].w * v0[j].w); s1 += (v1[j].x * v1[j].x + v1[j].y * v1[j].y) + (v1[j].z * v1[j].z + v1[j].w * v1[j].w); }
#pragma unroll
    for (int o = 1; o < 64; o <<= 1) { s0 += __shfl_xor(s0, o); s1 += __shfl_xor(s1, o); }
    const float r0 = 1.0f / sqrtf(s0 * (1.f / 1024.f) + EPS), r1 = 1.0f / sqrtf(s1 * (1.f / 1024.f) + EPS);
    u32x2* o0 = (u32x2*)oa + lane; u32x2* o1 = (u32x2*)ob + lane;
#pragma unroll
    for (int j = 0; j < 4; ++j) { const f32x4 g = gr[64 * j]; u32x2 w; w.x = pk2(v0[j].x * r0 * g.x, v0[j].y * r0 * g.y); w.y = pk2(v0[j].z * r0 * g.z, v0[j].w * r0 * g.w); o0[64 * j] = w;
        w.x = pk2(v1[j].x * r1 * g.x, v1[j].y * r1 * g.y); w.y = pk2(v1[j].z * r1 * g.z, v1[j].w * r1 * g.w); o1[64 * j] = w; }
}
__device__ __forceinline__ void rms_pass(const float* src, const float* gain, bf16* dst, int gw, int NGW, int lane) {
    int m = gw;
    for (; m + NGW < T; m += 2 * NGW) rms_rows2_to_bf16(src + (size_t)m * D, src + (size_t)(m + NGW) * D, gain, dst + (size_t)m * D, dst + (size_t)(m + NGW) * D, lane);
    if (m < T) rms_row_to_bf16(src + (size_t)m * D, gain, dst + (size_t)m * D, lane);
}

namespace att {
constexpr int QP = 768, OP = 512;
constexpr int KSTR = 208, VSTR = 144, OSTR = 144;
constexpr int KBUF = 64 * KSTR, VBUF = 64 * VSTR;
constexpr int L_K = 0, L_V = 2 * KBUF, L_OST = L_V + 2 * VBUF, L_END = L_OST + 8 * 32 * OSTR;
static_assert(L_END <= 131072, "attention LDS");
__device__ __forceinline__ int crow(int r, int hi) { return (r & 3) + 8 * (r >> 2) + 4 * hi; }
__device__ __forceinline__ void attn_unit(int b, int h, int qb, const bf16* Q, const bf16* K, const bf16* VT, bf16* O, const float* qhn, const float* CS, LAS unsigned char* lds) {
    const int tid = threadIdx.x, lane = tid & 63, r32 = lane & 31, hi = lane >> 5; const int wid = __builtin_amdgcn_readfirstlane(tid >> 6);
    const size_t rowbase = (size_t)b * SEQ; const int q0 = qb * 256, qw = q0 + wid * 32;
    bf16x8 qf[6];
    {
      const size_t qrow = rowbase + qw + r32;
      const bf16* qp = Q + qrow * QP + h * 96 + hi * 8;
      u32x4 raw[6];
#pragma unroll
      for (int ks = 0; ks < 6; ++ks) raw[ks] = *(const u32x4*)(qp + ks * 16);
      const f32x4 c0 = *(const f32x4*)(CS + qrow * 32 + 8 * hi), c1 = *(const f32x4*)(CS + qrow * 32 + 8 * hi + 4), s0 = *(const f32x4*)(CS + qrow * 32 + 16 + 8 * hi), s1 = *(const f32x4*)(CS + qrow * 32 + 16 + 8 * hi + 4);
      float v[6][8]; float ss = 0.f;
#pragma unroll
      for (int ks = 0; ks < 6; ++ks)
#pragma unroll
          for (int j = 0; j < 4; ++j) { v[ks][2 * j] = bflo(raw[ks][j]); v[ks][2 * j + 1] = bfhi(raw[ks][j]); ss += v[ks][2 * j] * v[ks][2 * j] + v[ks][2 * j + 1] * v[ks][2 * j + 1]; }
      ss += __shfl_xor(ss, 32);
      const float rstd = 1.0f / sqrtf(ss * (1.f / 96.f) + EPS);
#pragma unroll
      for (int ks = 0; ks < 6; ++ks) { const f32x4 g0 = *(const f32x4*)(qhn + 16 * ks + 8 * hi), g1 = *(const f32x4*)(qhn + 16 * ks + 8 * hi + 4);
#pragma unroll
          for (int j = 0; j < 4; ++j) { v[ks][j] *= rstd * g0[j]; v[ks][4 + j] *= rstd * g1[j]; } }
#pragma unroll
      for (int j = 0; j < 8; ++j) { const float cc = j < 4 ? c0[j & 3] : c1[j & 3], sn = j < 4 ? s0[j & 3] : s1[j & 3]; const float t1 = v[4][j], t2 = v[5][j]; v[4][j] = t1 * cc - t2 * sn; v[5][j] = t1 * sn + t2 * cc; }
      const float QSCALE = 0.10206207261596577f * 1.4426950408889634f;
#pragma unroll
      for (int ks = 0; ks < 6; ++ks) { u32x4 w;
#pragma unroll
          for (int j = 0; j < 4; ++j) w[j] = pk2(v[ks][2 * j] * QSCALE, v[ks][2 * j + 1] * QSCALE);
          qf[ks] = __builtin_bit_cast(bf16x8, w); } }
    f32x16 o0, o1, negm;
#pragma unroll
    for (int r = 0; r < 16; ++r) { o0[r] = 0.f; o1[r] = 0.f; negm[r] = 0.f; }
    float m_ref = 0.f, l_run = 0.f;
    const int NT = (q0 + 256) / 64;
    const int kk0 = tid / 12, kp0 = tid % 12, kk1 = (512 + tid) / 12, kp1 = (512 + tid) % 12;
    const bf16* Kg = K + rowbase * QP + h * 96;
    const bf16* Vg = VT + (size_t)(h * 64 + (tid >> 3)) * T + rowbase + (tid & 7) * 8;
    u32x4 kr0A, kr1A = (u32x4){0u, 0u, 0u, 0u}, vrA, kr0B, kr1B = (u32x4){0u, 0u, 0u, 0u}, vrB;
#define ATT_GLOAD(S, t) do { kr0##S = *(const u32x4*)(Kg + (size_t)((t) * 64 + kk0) * QP + kp0 * 8); if (tid < 256) kr1##S = *(const u32x4*)(Kg + (size_t)((t) * 64 + kk1) * QP + kp1 * 8); vr##S = *(const u32x4*)(Vg + (t) * 64); } while (0)
#define ATT_LSTORE(S, buf) do { *(LAS u32x4*)(lds + L_K + (buf) * KBUF + kk0 * KSTR + kp0 * 16) = kr0##S; if (tid < 256) *(LAS u32x4*)(lds + L_K + (buf) * KBUF + kk1 * KSTR + kp1 * 16) = kr1##S; \
        *(LAS u32x4*)(lds + L_V + (buf) * VBUF + (tid >> 3) * VSTR + (tid & 7) * 16) = vr##S; } while (0)
#define ATT_TILE(t, buf) do { const int k0 = (t) * 64; \
        if (k0 <= qw + 31) { \
            const LAS unsigned char* kb = lds + L_K + (buf) * KBUF + r32 * KSTR + hi * 16; \
            f32x16 p0, p1; \
            { const bf16x8 a0 = *(const LAS bf16x8*)(kb), a1 = *(const LAS bf16x8*)(kb + 32 * KSTR); \
              p0 = __builtin_amdgcn_mfma_f32_32x32x16_bf16(a0, qf[0], negm, 0, 0, 0); p1 = __builtin_amdgcn_mfma_f32_32x32x16_bf16(a1, qf[0], negm, 0, 0, 0); } \
            _Pragma("unroll") for (int ks = 1; ks < 6; ++ks) { \
                const bf16x8 a0 = *(const LAS bf16x8*)(kb + ks * 32), a1 = *(const LAS bf16x8*)(kb + 32 * KSTR + ks * 32); \
                p0 = __builtin_amdgcn_mfma_f32_32x32x16_bf16(a0, qf[ks], p0, 0, 0, 0); p1 = __builtin_amdgcn_mfma_f32_32x32x16_bf16(a1, qf[ks], p1, 0, 0, 0); } \
            if (k0 + 63 > qw) { const int q = qw + r32; \
                _Pragma("unroll") for (int r = 0; r < 16; ++r) { const int key = k0 + crow(r, hi); if (key > q) p0[r] = -1e30f; if (key + 32 > q) p1[r] = -1e30f; } } \
            float mxa = __builtin_fmaxf(__builtin_fmaxf(p0[0], p0[1]), p1[0]), mxb = __builtin_fmaxf(__builtin_fmaxf(p0[2], p0[3]), p1[1]); mxa = __builtin_fmaxf(__builtin_fmaxf(mxa, p1[2]), p1[3]); \
            _Pragma("unroll") for (int r = 4; r < 16; r += 4) { mxa = __builtin_fmaxf(__builtin_fmaxf(mxa, p0[r]), p0[r + 1]); mxb = __builtin_fmaxf(__builtin_fmaxf(mxb, p0[r + 2]), p0[r + 3]); \
                mxa = __builtin_fmaxf(__builtin_fmaxf(mxa, p1[r]), p1[r + 1]); mxb = __builtin_fmaxf(__builtin_fmaxf(mxb, p1[r + 2]), p1[r + 3]); } \
            float mx = __builtin_fmaxf(mxa, mxb); mx = __builtin_fmaxf(mx, __shfl_xor(mx, 32)); \
            if (__any(mx > 8.0f)) { const float dl = __builtin_fmaxf(mx, 0.f); m_ref += dl; const float al = __builtin_amdgcn_exp2f(-dl); l_run *= al; \
                _Pragma("unroll") for (int r = 0; r < 16; ++r) { p0[r] -= dl; p1[r] -= dl; o0[r] *= al; o1[r] *= al; negm[r] = -m_ref; } } \
            float rs0 = 0.f, rs1 = 0.f; \
            _Pragma("unroll") for (int r = 0; r < 16; ++r) { p0[r] = __builtin_amdgcn_exp2f(p0[r]); p1[r] = __builtin_amdgcn_exp2f(p1[r]); rs0 += p0[r]; rs1 += p1[r]; } \
            l_run += rs0 + rs1; \
            u32x4 pw[4]; \
            _Pragma("unroll") for (int j = 0; j < 4; ++j) { pw[0][j] = pk2(p0[2 * j], p0[2 * j + 1]); pw[1][j] = pk2(p0[8 + 2 * j], p0[8 + 2 * j + 1]); pw[2][j] = pk2(p1[2 * j], p1[2 * j + 1]); pw[3][j] = pk2(p1[8 + 2 * j], p1[8 + 2 * j + 1]); } \
            const LAS unsigned char* vb = lds + L_V + (buf) * VBUF + r32 * VSTR + hi * 8; \
            _Pragma("unroll") for (int ks = 0; ks < 4; ++ks) { \
                const bf16x8 pf = __builtin_bit_cast(bf16x8, pw[ks]); \
                { const s16x4 lo = *(const LAS s16x4*)(vb + ks * 32), hh = *(const LAS s16x4*)(vb + ks * 32 + 16); \
                  const bf16x8 vf = (bf16x8){lo[0], lo[1], lo[2], lo[3], hh[0], hh[1], hh[2], hh[3]}; \
                  o0 = __builtin_amdgcn_mfma_f32_32x32x16_bf16(vf, pf, o0, 0, 0, 0); } \
                { const s16x4 lo = *(const LAS s16x4*)(vb + 32 * VSTR + ks * 32), hh = *(const LAS s16x4*)(vb + 32 * VSTR + ks * 32 + 16); \
                  const bf16x8 vf = (bf16x8){lo[0], lo[1], lo[2], lo[3], hh[0], hh[1], hh[2], hh[3]}; \
                  o1 = __builtin_amdgcn_mfma_f32_32x32x16_bf16(vf, pf, o1, 0, 0, 0); } } \
        } } while (0)
    ATT_GLOAD(A, 0); ATT_LSTORE(A, 0); ATT_GLOAD(A, 1); ATT_GLOAD(B, 2); __syncthreads();
    for (int t = 0; t < NT; t += 2) {
        ATT_TILE(t, 0);
        ATT_LSTORE(A, 1);
        if (t + 3 < NT) ATT_GLOAD(A, t + 3);
        __syncthreads();
        ATT_TILE(t + 1, 1);
        if (t + 2 < NT) ATT_LSTORE(B, 0);
        if (t + 4 < NT) ATT_GLOAD(B, t + 4);
        __syncthreads();
    }
#undef ATT_GLOAD
#undef ATT_LSTORE
#undef ATT_TILE
    const float l = l_run + __shfl_xor(l_run, 32), inv = 1.0f / l;
    LAS unsigned char* stg = lds + L_OST + wid * (32 * OSTR);
#pragma unroll
    for (int r = 0; r < 16; ++r) { const int d = crow(r, hi);
        *(LAS unsigned short*)(stg + r32 * OSTR + d * 2) = (unsigned short)f2bf(o0[r] * inv);
        *(LAS unsigned short*)(stg + r32 * OSTR + (32 + d) * 2) = (unsigned short)f2bf(o1[r] * inv); }
    LDS_WAIT(); asm volatile("" ::: "memory");
    bf16* Ow = O + (rowbase + qw) * OP + h * 64;
#pragma unroll
    for (int i = 0; i < 4; ++i) { const int row = i * 8 + (lane >> 3), ch = lane & 7; const u32x4 v = *(const LAS u32x4*)(stg + row * OSTR + ch * 16); *(u32x4*)(Ow + (size_t)row * OP + ch * 8) = v; }
    LDS_WAIT(); asm volatile("" ::: "memory");
}
}

constexpr int NPH = 14;
struct Args { const void* in[24]; float* out; unsigned char* ws; int ph_lo, ph_hi; };
static_assert(sizeof(Args) == 24 * 8 + 8 + 8 + 8, "Args has no padding");

__global__ void __launch_bounds__(NWAVES * 64, 2) fwd_kernel(Args args) {
    extern __shared__ __attribute__((aligned(16))) unsigned char lds_raw[];
    LAS unsigned char* lds = (LAS unsigned char*)lds_raw;
    cg::grid_group grid = cg::this_grid();
    const int tid = threadIdx.x, lane = tid & 63, wave = __builtin_amdgcn_readfirstlane(tid >> 6);
    const int G = gridDim.x, bx = blockIdx.x;
    const int gw = bx * NWAVES + wave, NGW = G * NWAVES;
    unsigned char* ws = args.ws;
    const float* x = (const float*)args.in[0]; const int* positions = (const int*)args.in[1];
    float* out = args.out;
    bf16* W1GU = (bf16*)(ws + WS_W1GU); bf16* W1D = (bf16*)(ws + WS_W1D); bf16* WIN = (bf16*)(ws + WS_WIN); bf16* WUQ = (bf16*)(ws + WS_WUQ);
    bf16* WUK = (bf16*)(ws + WS_WUK); bf16* WUV = (bf16*)(ws + WS_WUV); bf16* WPA = (bf16*)(ws + WS_WPA); bf16* WPC = (bf16*)(ws + WS_WPC);
    bf16* WOUT = (bf16*)(ws + WS_WOUT); bf16* W2GU = (bf16*)(ws + WS_W2GU); bf16* W2D = (bf16*)(ws + WS_W2D);
    bf16* XN = (bf16*)(ws + WS_XN); bf16* ZB = (bf16*)(ws + WS_ZB); bf16* HB = (bf16*)(ws + WS_H); bf16* UB = (bf16*)(ws + WS_U); bf16* GBB = (bf16*)(ws + WS_GB);
    bf16* LAT = (bf16*)(ws + WS_LAT); bf16* GATES = (bf16*)(ws + WS_GATES); bf16* QN = (bf16*)(ws + WS_QN); bf16* CKV = (bf16*)(ws + WS_CKV);
    bf16* QB = (bf16*)(ws + WS_Q); bf16* KB = (bf16*)(ws + WS_K); bf16* VT = (bf16*)(ws + WS_VT); bf16* AO = (bf16*)(ws + WS_AO); bf16* MG = (bf16*)(ws + WS_MG); bf16* M1 = (bf16*)(ws + 184 * MiB); float* CS = (float*)(ws + WS_CS);
    const int lo = args.ph_lo, hi = args.ph_hi;
#ifndef PH_MASK
#define PH_MASK 0xFFFF
#endif
#define IN(k) (((PH_MASK >> (k)) & 1) && lo <= (k) && (k) < hi)
    LAS unsigned* misc = (LAS unsigned*)(lds + 131072 + 256);
    if (tid < 64) misc[tid] = 0u;
    __syncthreads();
    XcdBarrier xbar = xcd_barrier_post((unsigned*)ws, (volatile LAS unsigned*)(misc + 8));
    if (hi > NPH) grid.sync();
#define SEAM(k) do { if (IN(k) && IN((k) + 1)) xcd_barrier(xbar); } while (0)

#ifdef NANFILL
    if (lo == 0) {
        for (int i = tid; i < LDS_BYTES / 16; i += 512) *((LAS u32x4*)lds + i) = (u32x4){0x7fc07fc0u, 0x7fc07fc0u, 0x7fc07fc0u, 0x7fc07fc0u};
        __syncthreads();
        u32x4* wsv = (u32x4*)(ws + 120 * MiB);
        for (size_t i = (size_t)bx * 512 + tid; i < (size_t)(376 * MiB / 16); i += (size_t)G * 512) wsv[i] = (u32x4){0x7fc07fc0u, 0x7fc07fc0u, 0x7fc07fc0u, 0x7fc07fc0u};
    }
#endif
#ifndef REPE
#define REPE 1
#endif
    if (IN(0)) for (int repe = 0; repe < REPE; ++repe) {
        LAS float* scr = (LAS float*)(lds + wave * 16384);
        constexpr int I_G = 16 * 88, I_D = 44 * 32, I_IN = 16 * 181, I_UQ = 6 * 24, I_UK = 4 * 16, I_PA = 8 * 32, I_SQ = 16 * 32;
        constexpr int NITEMS = 2 * (2 * I_G + I_D) + I_IN + I_UQ + 2 * I_UK + I_PA + 2 * I_SQ;
        for (int it = gw; it < NITEMS; it += NGW) {
            int r = it;
            if (r < I_G) { p0_transpose_item((const float*)args.in[3], 1024, FF, W1GU, MAP_GATE, scr, r, lane); continue; } r -= I_G;
            if (r < I_G) { p0_transpose_item((const float*)args.in[4], 1024, FF, W1GU, MAP_UP, scr, r, lane); continue; } r -= I_G;
            if (r < I_D) { p0_transpose_item((const float*)args.in[5], FF, 1024, W1D, MAP_ID, scr, r, lane); continue; } r -= I_D;
            if (r < I_G) { p0_transpose_item((const float*)args.in[21], 1024, FF, W2GU, MAP_GATE, scr, r, lane); continue; } r -= I_G;
            if (r < I_G) { p0_transpose_item((const float*)args.in[22], 1024, FF, W2GU, MAP_UP, scr, r, lane); continue; } r -= I_G;
            if (r < I_D) { p0_transpose_item((const float*)args.in[23], FF, 1024, W2D, MAP_ID, scr, r, lane); continue; } r -= I_D;
            if (r < I_IN) { p0_transpose_item((const float*)args.in[7], 1024, NIN, WIN, MAP_WIN, scr, r, lane); continue; } r -= I_IN;
            if (r < I_UQ) { p0_transpose_item((const float*)args.in[10], 384, 768, WUQ, MAP_ID, scr, r, lane); continue; } r -= I_UQ;
            if (r < I_UK) { p0_transpose_item((const float*)args.in[12], 256, 512, WUK, MAP_UK, scr, r, lane); continue; } r -= I_UK;
            if (r < I_UK) { p0_transpose_item((const float*)args.in[13], 256, 512, WUV, MAP_ID, scr, r, lane); continue; } r -= I_UK;
            if (r < I_PA) { p0_transpose_item((const float*)args.in[16], 512, 1024, WPA, MAP_ID, scr, r, lane); continue; } r -= I_PA;
            if (r < I_SQ) { p0_transpose_item((const float*)args.in[18], 1024, 1024, WPC, MAP_ID, scr, r, lane); continue; } r -= I_SQ;
            p0_transpose_item((const float*)args.in[19], 1024, 1024, WOUT, MAP_ID, scr, r, lane);
        }
        for (int i = bx * 512 + tid; i < 12288; i += G * 512) *((u32x4*)(WIN + (size_t)672 * 1024) + i) = (u32x4){0u, 0u, 0u, 0u};
        rms_pass(x, (const float*)args.in[2], XN, gw, NGW, lane);
    }
    SEAM(0);
#ifndef REP1
#define REP1 1
#endif
    if (IN(1)) for (int rep1 = 0; rep1 < REP1; ++rep1) {
        pg8::Gemm g{XN, W1GU, T, 2 * FF, D}; pg8::StaticOrder S; S.init(T, 2 * FF, G, bx);
        pg8::EpiSwiglu E{HB, FF};
        pg8::gemm_phase<pg8::EpiSwiglu, pg8::StaticOrder, true, true>(lds, g, S, E);
    }
    SEAM(1);
    if (IN(2)) {
        pg8::Gemm g{HB, W1D, T, D, FF}; pg8::StaticOrder S; S.init(T, D, G, bx);
        pg8::EpiResF32 E{x, out, D, 0.5f};
        pg8::gemm_phase<pg8::EpiResF32, pg8::StaticOrder, true, true>(lds, g, S, E);
    }
    SEAM(2);
    if (IN(3)) for (int repe = 0; repe < REPE; ++repe) rms_pass(out, (const float*)args.in[6], XN, gw, NGW, lane);
    SEAM(3);
    if (IN(4)) {
        pg8::Gemm g{XN, WIN, T, NINP, D}; pg8::StaticOrder S; S.init(T, NINP, G, bx);
        pg8::EpiWin E{LAT, UB, GBB, GATES, (const float*)args.in[8]};
        pg8::gemm_phase<pg8::EpiWin, pg8::StaticOrder, true, true>(lds, g, S, E);
    }
    SEAM(4);
    if (IN(5)) for (int repe = 0; repe < REPE; ++repe) {
        const float* qg = (const float*)args.in[9]; const float* kg = (const float*)args.in[11]; const float* cw = (const float*)args.in[17];
        f32x4 cwv[2][3][2];
#pragma unroll
        for (int hh = 0; hh < 2; ++hh)
#pragma unroll
            for (int k = 0; k < 3; ++k) { cwv[hh][k][0] = *(const f32x4*)(cw + 1024 * k + 512 * hh + 8 * lane); cwv[hh][k][1] = *(const f32x4*)(cw + 1024 * k + 512 * hh + 8 * lane + 4); }
        for (int m = gw; m < T; m += NGW) {
            const bf16* lr = LAT + (size_t)m * 768;
            u32x4 qv = (u32x4){0u, 0u, 0u, 0u}, kv = (u32x4){0u, 0u, 0u, 0u};
            if (lane < 48) qv = *(const u32x4*)(lr + 8 * lane);
            if (lane < 32) kv = *(const u32x4*)(lr + 384 + 8 * lane);
            float qf[8], kf[8]; float sq = 0.f, sk = 0.f;
#pragma unroll
            for (int j = 0; j < 4; ++j) { qf[2 * j] = bflo(qv[j]); qf[2 * j + 1] = bfhi(qv[j]); kf[2 * j] = bflo(kv[j]); kf[2 * j + 1] = bfhi(kv[j]); }
#pragma unroll
            for (int j = 0; j < 8; ++j) { sq += qf[j] * qf[j]; sk += kf[j] * kf[j]; }
            const float rq = 1.0f / sqrtf(wave_sum(sq) * (1.f / 384.f) + EPS), rk = 1.0f / sqrtf(wave_sum(sk) * (1.f / 256.f) + EPS);
            if (lane < 48) { const f32x4 g0 = *(const f32x4*)(qg + 8 * lane), g1 = *(const f32x4*)(qg + 8 * lane + 4); u32x4 w;
                w.x = pk2(qf[0] * rq * g0.x, qf[1] * rq * g0.y); w.y = pk2(qf[2] * rq * g0.z, qf[3] * rq * g0.w); w.z = pk2(qf[4] * rq * g1.x, qf[5] * rq * g1.y); w.w = pk2(qf[6] * rq * g1.z, qf[7] * rq * g1.w);
                *(u32x4*)(QN + (size_t)m * 384 + 8 * lane) = w; }
            if (lane < 32) { const f32x4 g0 = *(const f32x4*)(kg + 8 * lane), g1 = *(const f32x4*)(kg + 8 * lane + 4); u32x4 w;
                w.x = pk2(kf[0] * rk * g0.x, kf[1] * rk * g0.y); w.y = pk2(kf[2] * rk * g0.z, kf[3] * rk * g0.w); w.z = pk2(kf[4] * rk * g1.x, kf[5] * rk * g1.y); w.w = pk2(kf[6] * rk * g1.z, kf[7] * rk * g1.w);
                *(u32x4*)(CKV + (size_t)m * 256 + 8 * lane) = w; }
            if (lane < 16) { const float invf = __builtin_amdgcn_exp2f(-(float)lane * (13.287712379549449f / 16.0f)); const float ang = (float)positions[m] * invf;
                double rev = (double)ang * 0.15915494309189535; rev -= floor(rev); const float rf = (float)rev;
                CS[(size_t)m * 32 + lane] = __builtin_amdgcn_cosf(rf); CS[(size_t)m * 32 + 16 + lane] = __builtin_amdgcn_sinf(rf); }
            const int tpos = m & (SEQ - 1);
#pragma unroll
            for (int hh = 0; hh < 2; ++hh) {
                const int c = 512 * hh + 8 * lane;
                const u32x4 u0 = *(const u32x4*)(UB + (size_t)m * 1024 + c);
                u32x4 u1 = (u32x4){0u, 0u, 0u, 0u}, u2 = (u32x4){0u, 0u, 0u, 0u};
                if (tpos >= 1) u1 = *(const u32x4*)(UB + (size_t)(m - 1) * 1024 + c);
                if (tpos >= 2) u2 = *(const u32x4*)(UB + (size_t)(m - 2) * 1024 + c);
                const u32x4 gb = *(const u32x4*)(GBB + (size_t)m * 1024 + c);
                u32x4 w;
#pragma unroll
                for (int j = 0; j < 4; ++j) {
                    const int e0 = (2 * j) & 3, e1 = (2 * j + 1) & 3, hv = j >> 1;
                    const float za = cwv[hh][0][hv][e0] * bflo(u2[j]) + cwv[hh][1][hv][e0] * bflo(u1[j]) + cwv[hh][2][hv][e0] * bflo(u0[j]);
                    const float zb = cwv[hh][0][hv][e1] * bfhi(u2[j]) + cwv[hh][1][hv][e1] * bfhi(u1[j]) + cwv[hh][2][hv][e1] * bfhi(u0[j]);
                    w[j] = pk2(bflo(gb[j]) * za, bfhi(gb[j]) * zb);
                }
                *(u32x4*)(ZB + (size_t)m * 1024 + c) = w;
            }
        }
    }
    SEAM(5);
    if (IN(6)) {
#ifndef P6_MASK
#define P6_MASK 7
#endif
        if (P6_MASK & 1) { pg8::Gemm g{QN, WUQ, T, 768, 384}; pg8::StaticOrder S; S.init(T, 768, G, bx); pg8::EpiBf16<false> E{QB, 768};
          pg8::gemm_phase<pg8::EpiBf16<false>, pg8::StaticOrder, true, true>(lds, g, S, E); }
        if (P6_MASK & 2) { pg8::Gemm g{CKV, WUK, T, 512, 256}; pg8::StaticOrder S; S.init(T, 512, G, bx); pg8::EpiKnorm E{KB, LAT, CS, (const float*)args.in[15]};
          pg8::gemm_phase<pg8::EpiKnorm, pg8::StaticOrder, true, true>(lds, g, S, E); }
        if (P6_MASK & 4) { pg8::Gemm g{WUV, CKV, 512, T, 256}; pg8::StaticOrder S; S.init(512, T, G, bx); pg8::EpiBf16<false> E{VT, T};
          pg8::gemm_phase<pg8::EpiBf16<false>, pg8::StaticOrder, true, true>(lds, g, S, E); }
    }
    SEAM(6);
#ifndef REP8
#define REP8 1
#endif
    if (IN(8)) {
        for (int rep8 = 0; rep8 < REP8; ++rep8)
        for (int item = bx; item < 256; item += G) {
            const int v = (item % 8) * 32 + item / 8;
            const int s = v & 3, gq2 = v >> 2;
#pragma unroll 1
            for (int i = 0; i < 4; ++i) {
                const int bh = 2 * gq2 + (i >> 1), qb = (i & 1) ? 7 - s : s;
                att::attn_unit(bh >> 3, bh & 7, qb, QB, KB, VT, AO, (const float*)args.in[14], CS, lds);
            }
        }
    }
    SEAM(8);
    if (IN(9)) {
        { pg8::Gemm g{AO, WPA, T, D, 512}; pg8::StaticOrder S; S.init(T, D, G, bx); pg8::EpiGate<false> E{M1, GATES, 2048, nullptr};
          pg8::gemm_phase<pg8::EpiGate<false>, pg8::StaticOrder, true, true>(lds, g, S, E); }
        { pg8::Gemm g{ZB, WPC, T, D, D}; pg8::StaticOrder S; S.init(T, D, G, bx); pg8::EpiGate<true> E{MG, GATES + 1024, 2048, M1};
          pg8::gemm_phase<pg8::EpiGate<true>, pg8::StaticOrder, true, true>(lds, g, S, E); }
    }
    SEAM(9);
    if (IN(10)) {
        pg8::Gemm g{MG, WOUT, T, D, D}; pg8::StaticOrder S; S.init(T, D, G, bx);
        pg8::EpiResF32 E{out, out, D, 1.0f};
        pg8::gemm_phase<pg8::EpiResF32, pg8::StaticOrder, true, true>(lds, g, S, E);
    }
    SEAM(10);
    if (IN(11)) for (int repe = 0; repe < REPE; ++repe) rms_pass(out, (const float*)args.in[20], XN, gw, NGW, lane);
    SEAM(11);
    if (IN(12)) {
        pg8::Gemm g{XN, W2GU, T, 2 * FF, D}; pg8::StaticOrder S; S.init(T, 2 * FF, G, bx);
        pg8::EpiSwiglu E{HB, FF};
        pg8::gemm_phase<pg8::EpiSwiglu, pg8::StaticOrder, true, true>(lds, g, S, E);
    }
    SEAM(12);
    if (IN(13)) {
        pg8::Gemm g{HB, W2D, T, D, FF}; pg8::StaticOrder S; S.init(T, D, G, bx);
        pg8::EpiResF32 E{out, out, D, 0.5f};
        pg8::gemm_phase<pg8::EpiResF32, pg8::StaticOrder, true, true>(lds, g, S, E);
    }
#ifdef EXTRA_SYNCS
    for (int e = 0; e < EXTRA_SYNCS; ++e) xcd_barrier(xbar);
#endif
#undef IN
#undef SEAM
}


#ifndef DUMP
#define DUMP 0
#endif
#if DUMP
__device__ __forceinline__ float ldbf(const bf16* p) { return __uint_as_float(((unsigned)*p) << 16); }
__global__ void dump_kernel(float* out, unsigned char* ws) {
    const bf16* HB = (const bf16*)(ws + WS_H); const bf16* LAT = (const bf16*)(ws + WS_LAT); const bf16* UB = (const bf16*)(ws + WS_U); const bf16* GBB = (const bf16*)(ws + WS_GB);
    const bf16* GATES = (const bf16*)(ws + WS_GATES); const bf16* ZB = (const bf16*)(ws + WS_ZB); const bf16* QN = (const bf16*)(ws + WS_QN); const bf16* CKV = (const bf16*)(ws + WS_CKV);
    const bf16* QB = (const bf16*)(ws + WS_Q); const bf16* KB = (const bf16*)(ws + WS_K); const bf16* VT = (const bf16*)(ws + WS_VT); const bf16* AO = (const bf16*)(ws + WS_AO); const bf16* MG = (const bf16*)(ws + WS_MG);
    for (size_t i = (size_t)blockIdx.x * blockDim.x + threadIdx.x; i < (size_t)T * D; i += (size_t)gridDim.x * blockDim.x) {
        const size_t m = i / D; const int c = (int)(i % D); float v = 0.f;
        if (DUMP == 1) { v = ldbf(HB + m * FF + c) + ldbf(HB + m * FF + 1024 + c) + (c < 768 ? ldbf(HB + m * FF + 2048 + c) : 0.f); }
        if (DUMP == 4) { v = (c < 672 ? ldbf(LAT + m * 768 + c) : 0.f) + ldbf(UB + m * 1024 + c) + ldbf(GBB + m * 1024 + c) + ldbf(GATES + m * 2048 + c) + ldbf(GATES + m * 2048 + 1024 + c); }
        if (DUMP == 5) { v = ldbf(ZB + m * 1024 + c) + ldbf(QN + m * 384 + c % 384) + ldbf(CKV + m * 256 + c % 256); }
        if (DUMP == 7) { v = ldbf(QB + m * 768 + c % 768) + ldbf(KB + m * 768 + c % 768) + ldbf(VT + (size_t)(c % 512) * T + m); }
        if (DUMP == 8) { v = ldbf(AO + m * 512 + c % 512); }
        if (DUMP == 9) { v = ldbf(MG + m * 1024 + c); }
        out[i] = v;
    }
}
#endif
#ifndef MK_ONE_LAUNCH
#define MK_ONE_LAUNCH 0
#endif
extern "C" void kernel_launch(void* const* d_in, const int* in_sizes, int n_in, void* d_out, int out_size, void* d_ws, size_t ws_size, hipStream_t stream) {
    static int grid = 0;
    if (grid == 0) {
        if (n_in != 24 || in_sizes[0] != T * D || out_size != T * D || ws_size < WS_END) { fprintf(stderr, "kernel_launch: unexpected shapes (n_in %d, in0 %d, out %d, ws %zu)\n", n_in, n_in > 0 ? in_sizes[0] : -1, out_size, ws_size); grid = -1; return; }
        int dev = 0, cus = 0, per_cu = 0;
        if (hipGetDevice(&dev) != hipSuccess || hipDeviceGetAttribute(&cus, hipDeviceAttributeMultiprocessorCount, dev) != hipSuccess) { grid = -1; return; }
        if (hipFuncSetAttribute((const void*)fwd_kernel, hipFuncAttributeMaxDynamicSharedMemorySize, LDS_BYTES) != hipSuccess) { fprintf(stderr, "kernel_launch: hipFuncSetAttribute failed\n"); grid = -1; return; }
        if (hipOccupancyMaxActiveBlocksPerMultiprocessor(&per_cu, (const void*)fwd_kernel, NWAVES * 64, LDS_BYTES) != hipSuccess || per_cu < 1) { fprintf(stderr, "kernel_launch: occupancy query says %d\n", per_cu); per_cu = 1; }
        (void)hipGetLastError();
        grid = cus * 1;
    }
    if (grid < 0) return;
    if (hipMemsetAsync(d_ws, 0, 16384, stream) != hipSuccess) { fprintf(stderr, "kernel_launch: memset of the barrier words failed\n"); return; }
    Args a{};
    for (int i = 0; i < 24; ++i) a.in[i] = d_in[i];
    a.out = (float*)d_out; a.ws = (unsigned char*)d_ws;
#if MK_ONE_LAUNCH
    a.ph_lo = 0; a.ph_hi = NPH;
    void* kargs[] = {&a};
    hipError_t e = hipLaunchCooperativeKernel((const void*)fwd_kernel, dim3(grid), dim3(NWAVES * 64), kargs, LDS_BYTES, stream);
    if (e != hipSuccess) fprintf(stderr, "kernel_launch: cooperative launch failed: %s (grid %d)\n", hipGetErrorString(e), grid);
#else
#ifndef STOP_AFTER
#define STOP_AFTER (NPH - 1)
#endif
    for (int p = 0; p <= STOP_AFTER; ++p) {
        a.ph_lo = p; a.ph_hi = p + 1;
        hipLaunchKernelGGL(fwd_kernel, dim3(grid), dim3(NWAVES * 64), LDS_BYTES, stream, a);
    }
#if DUMP
    if (DUMP != 2 && DUMP != 10) hipLaunchKernelGGL(dump_kernel, dim3(2048), dim3(256), 0, stream, (float*)d_out, (unsigned char*)d_ws);
#endif
#endif
}
```

```cpp
#define MK_ONE_LAUNCH 1
#include <hip/hip_runtime.h>
#include <hip/hip_cooperative_groups.h>
#include <cstdio>
#include <cstdint>
namespace cg = cooperative_groups;
namespace pg8 {
#define PG8_LAS __attribute__((address_space(3)))
typedef unsigned short bf16_t;
typedef short bf16x8 __attribute__((ext_vector_type(8)));
typedef float f32x4 __attribute__((ext_vector_type(4)));
typedef unsigned u32x4 __attribute__((ext_vector_type(4)));
constexpr int BM = 256, BK = 64, HALF = 128, HTB = HALF * BK * 2  , STAGE_BYTES = 8 * HTB, NXCD = 8, WGM = 8;

__host__ __device__ __forceinline__ int lds_byte(int r, int c) { const int st = (r >> 4) * 2 + (c >> 5), rr = r & 15, cc = c & 31, ob = rr * 64 + cc * 2; return st * 1024 + (ob ^ (((ob >> 9) & 1) << 5)); }
__host__ __device__ __forceinline__ void stage_rc(int b, int& R, int& C) { const int st = b / 1024, sb = b % 1024, swz = sb ^ (((sb >> 9) & 1) << 5); R = (st >> 1) * 16 + swz / 64; C = (st & 1) * 32 + (swz % 64) / 2; }
__host__ __device__ __forceinline__ int perm32(int rho) { const int n = rho >> 4, i = rho & 15; return 8 * (i >> 2) + 4 * n + (i & 3); }

struct Unit { int pm, pn; };
struct Gemm { const bf16_t* A; const bf16_t* Bt; int M, N, K; };

struct StaticOrder {
    int nM, nN, nwg, G, c;
    __host__ __device__ void init(int M, int N, int G_, int c_) { nM = M / BM; nN = N / BM; nwg = nM * nN; G = G_; c = c_; }
    __host__ __device__ bool next(int i, Unit& u) const {
        const long L = (long)i * G + c; if (L >= nwg) return false;
        int wgid = (int)L; { const int q = nwg / NXCD, r = nwg % NXCD, xcd = wgid % NXCD, off = wgid / NXCD; wgid = (xcd < r ? xcd * (q + 1) : r * (q + 1) + (xcd - r) * q) + off; }
        const int nig = WGM * nN, gid = wgid / nig, fm = gid * WGM, gsz = (nM - fm) < WGM ? (nM - fm) : WGM;
        u.pm = fm + ((wgid % nig) % gsz); u.pn = (wgid % nig) / gsz; return true;
    }
    __device__ __forceinline__ void a_ready(const Unit&) const {}
    __device__ __forceinline__ void done(const Unit&) const {}
};

typedef float cvt_f32x2 __attribute__((ext_vector_type(2))); typedef __bf16 cvt_bf16x2 __attribute__((ext_vector_type(2)));
__device__ __forceinline__ unsigned cvt_pk_bf16(float lo, float hi) { const cvt_f32x2 v = {lo, hi}; const cvt_bf16x2 b = __builtin_convertvector(v, cvt_bf16x2); return __builtin_bit_cast(unsigned, b); }
typedef float f32x2 __attribute__((ext_vector_type(2)));
__device__ __forceinline__ float fast_sigmoid(float v) { return __builtin_amdgcn_rcpf(1.0f + __builtin_amdgcn_exp2f(-1.4426950408889634f * v)); }
__device__ __forceinline__ u32x4 pack8(const f32x4 v0, const f32x4 v1) { u32x4 w; w.x = cvt_pk_bf16(v0[0], v0[1]); w.y = cvt_pk_bf16(v0[2], v0[3]); w.z = cvt_pk_bf16(v1[0], v1[1]); w.w = cvt_pk_bf16(v1[2], v1[3]); return w; }
__device__ __forceinline__ float bf_lo(unsigned w) { return __uint_as_float(w << 16); }
__device__ __forceinline__ float bf_hi(unsigned w) { return __uint_as_float(w & 0xffff0000u); }
__device__ __forceinline__ void unpack8(const u32x4 w, f32x4& v0, f32x4& v1) { v0 = (f32x4){bf_lo(w.x), bf_hi(w.x), bf_lo(w.y), bf_hi(w.y)}; v1 = (f32x4){bf_lo(w.z), bf_hi(w.z), bf_lo(w.w), bf_hi(w.w)}; }

struct EpiSwiglu {
    static constexpr bool PERM = true, AFTER_DRAIN = false;
    bf16_t* H; int ldh;
    __device__ __forceinline__ void operator()(const f32x4 (&acc)[2][2][4][2], const Unit& u, int wr, int wc, int fr, int fq) const {
        const int row0 = u.pm * BM + wr * 64 + fr, col0 = u.pn * HALF + wc * 32 + 8 * fq;
#pragma unroll
        for (int ai = 0; ai < 2; ++ai)
#pragma unroll
            for (int m = 0; m < 4; ++m) {
                f32x4 h[2];
#pragma unroll
                for (int n = 0; n < 2; ++n) { const f32x4 g = acc[ai][0][m][n], up = acc[ai][1][m][n];
                    const f32x4 t = g * (-1.4426950408889634f); f32x4 e;
#pragma unroll
                    for (int i = 0; i < 4; ++i) e[i] = __builtin_amdgcn_exp2f(t[i]);
                    const f32x4 d = e + 1.0f; f32x4 r;
#pragma unroll
                    for (int i = 0; i < 4; ++i) r[i] = __builtin_amdgcn_rcpf(d[i]);
                    h[n] = (g * up) * r; }
                __builtin_nontemporal_store(pack8(h[0], h[1]), (u32x4*)(H + (size_t)(row0 + ai * HALF + m * 16) * ldh + col0));
            }
    }
};
struct EpiResF32 {
    static constexpr bool PERM = false, AFTER_DRAIN = false;
    const float* base; float* out; int ldc; float scale;
    __device__ __forceinline__ void operator()(const f32x4 (&acc)[2][2][4][2], const Unit& u, int wr, int wc, int fr, int fq) const {
        const int row0 = u.pm * BM + wr * 64 + fr, col0 = u.pn * BM + wc * 32 + 4 * fq;
#pragma unroll
        for (int ai = 0; ai < 2; ++ai)
#pragma unroll
            for (int m = 0; m < 4; ++m) { const size_t off = (size_t)(row0 + ai * HALF + m * 16) * ldc + col0;
#pragma unroll
                for (int bj = 0; bj < 2; ++bj)
#pragma unroll
                    for (int n = 0; n < 2; ++n) { const f32x4 b = *(const f32x4*)(base + off + bj * HALF + n * 16); *(f32x4*)(out + off + bj * HALF + n * 16) = b + acc[ai][bj][m][n] * scale; }
                if (m & 1) asm volatile("" ::: "memory"); }
    }
};
template <bool REMAP> struct EpiBf16 {
    static constexpr bool PERM = true, AFTER_DRAIN = false;
    bf16_t* O; int ldc;
    __device__ __forceinline__ void operator()(const f32x4 (&acc)[2][2][4][2], const Unit& u, int wr, int wc, int fr, int fq) const {
        const int row0 = u.pm * BM + wr * 64 + fr, c0 = u.pn * BM + wc * 32 + 8 * fq;
#pragma unroll
        for (int ai = 0; ai < 2; ++ai)
#pragma unroll
            for (int m = 0; m < 4; ++m) { bf16_t* rowp = O + (size_t)(row0 + ai * HALF + m * 16) * ldc;
#pragma unroll
                for (int bj = 0; bj < 2; ++bj) { const int c = c0 + bj * HALF; const int dc = REMAP ? ((c >> 6) * 96 + (c & 63)) : c;
                    *(u32x4*)(rowp + dc) = pack8(acc[ai][bj][m][0], acc[ai][bj][m][1]); } }
    }
};
struct EpiWin {
    static constexpr bool PERM = true, AFTER_DRAIN = false;
    bf16_t *LAT, *U, *GB, *GATES; const float* gate_bias;
    __device__ __forceinline__ void operator()(const f32x4 (&acc)[2][2][4][2], const Unit& u, int wr, int wc, int fr, int fq) const {
        const int row0 = u.pm * BM + wr * 64 + fr, cw = wc * 32 + 8 * fq; const int pn = u.pn;
        if (pn >= 3 && pn < 11) {
#pragma unroll
            for (int ai = 0; ai < 2; ++ai)
#pragma unroll
                for (int m = 0; m < 4; ++m)
                    __builtin_nontemporal_store(pack8(acc[ai][0][m][0] * acc[ai][1][m][0], acc[ai][0][m][1] * acc[ai][1][m][1]), (u32x4*)(U + (size_t)(row0 + ai * HALF + m * 16) * 1024 + (pn - 3) * HALF + cw));
        } else if (pn >= 15) {
            f32x4 bv[2][2];
#pragma unroll
            for (int bj = 0; bj < 2; ++bj)
#pragma unroll
                for (int n = 0; n < 2; ++n) bv[bj][n] = *(const f32x4*)(gate_bias + (pn - 15) * BM + bj * HALF + cw + 4 * n);
#pragma unroll
            for (int ai = 0; ai < 2; ++ai)
#pragma unroll
                for (int m = 0; m < 4; ++m)
#pragma unroll
                    for (int bj = 0; bj < 2; ++bj) { f32x4 s[2];
#pragma unroll
                        for (int n = 0; n < 2; ++n) { const f32x4 v = acc[ai][bj][m][n] + bv[bj][n];
#pragma unroll
                            for (int i = 0; i < 4; ++i) s[n][i] = fast_sigmoid(v[i]); }
                        __builtin_nontemporal_store(pack8(s[0], s[1]), (u32x4*)(GATES + (size_t)(row0 + ai * HALF + m * 16) * 2048 + (pn - 15) * BM + bj * HALF + cw)); }
        } else {
            bf16_t* O = pn < 3 ? LAT : GB; const int ldc = pn < 3 ? 768 : 1024; const int ct = pn < 3 ? pn * BM : (pn - 11) * BM;
#pragma unroll
            for (int ai = 0; ai < 2; ++ai)
#pragma unroll
                for (int m = 0; m < 4; ++m)
#pragma unroll
                    for (int bj = 0; bj < 2; ++bj)
                        __builtin_nontemporal_store(pack8(acc[ai][bj][m][0], acc[ai][bj][m][1]), (u32x4*)(O + (size_t)(row0 + ai * HALF + m * 16) * ldc + ct + bj * HALF + cw));
        }
    }
};
template <bool ADD> struct EpiGate {
    static constexpr bool PERM = true, AFTER_DRAIN = false;
    bf16_t* Mg; const bf16_t* G; int ldg; const bf16_t* Prev;
    __device__ __forceinline__ void operator()(const f32x4 (&acc)[2][2][4][2], const Unit& u, int wr, int wc, int fr, int fq) const {
        const int row0 = u.pm * BM + wr * 64 + fr, c0 = u.pn * BM + wc * 32 + 8 * fq;
#pragma unroll
        for (int ai = 0; ai < 2; ++ai)
#pragma unroll
            for (int m = 0; m < 4; ++m) { const size_t r = (size_t)(row0 + ai * HALF + m * 16);
#pragma unroll
                for (int bj = 0; bj < 2; ++bj) { const int c = c0 + bj * HALF;
                    f32x4 g0, g1; unpack8(*(const u32x4*)(G + r * ldg + c), g0, g1);
                    f32x4 v0 = g0 * acc[ai][bj][m][0], v1 = g1 * acc[ai][bj][m][1];
                    if (ADD) { f32x4 p0, p1; unpack8(*(const u32x4*)(Prev + r * 1024 + c), p0, p1); v0 += p0; v1 += p1; }
                    *(u32x4*)(Mg + r * 1024 + c) = pack8(v0, v1); } }
    }
};

struct EpiKnorm {
    static constexpr bool PERM = true, AFTER_DRAIN = false;
    bf16_t* K; const bf16_t* LAT; const float* CS; const float* gk;
    __device__ __forceinline__ void operator()(const f32x4 (&acc)[2][2][4][2], const Unit& u, int wr, int wc, int fr, int fq) const {
        typedef unsigned u32x2e __attribute__((ext_vector_type(2)));
        const int head = u.pn * 4 + wc, row0 = u.pm * BM + wr * 64 + fr;
        f32x4 gn[2][2];
#pragma unroll
        for (int bj = 0; bj < 2; ++bj)
#pragma unroll
            for (int n = 0; n < 2; ++n) gn[bj][n] = *(const f32x4*)(gk + 32 * bj + 8 * fq + 4 * n);
        const f32x4 g1 = *(const f32x4*)(gk + 64 + 4 * fq), g2 = *(const f32x4*)(gk + 80 + 4 * fq);
#pragma unroll
        for (int ai = 0; ai < 2; ++ai)
#pragma unroll
            for (int m = 0; m < 4; ++m) {
                const size_t row = (size_t)(row0 + ai * HALF + m * 16);
                const u32x2e w1 = *(const u32x2e*)(LAT + row * 768 + 640 + 4 * fq), w2 = *(const u32x2e*)(LAT + row * 768 + 656 + 4 * fq);
                f32x4 t1 = (f32x4){bf_lo(w1.x), bf_hi(w1.x), bf_lo(w1.y), bf_hi(w1.y)}, t2 = (f32x4){bf_lo(w2.x), bf_hi(w2.x), bf_lo(w2.y), bf_hi(w2.y)};
                const f32x4 cs = *(const f32x4*)(CS + row * 32 + 4 * fq), sn = *(const f32x4*)(CS + row * 32 + 16 + 4 * fq);
                float ss = (t1[0] * t1[0] + t1[1] * t1[1]) + (t1[2] * t1[2] + t1[3] * t1[3]) + (t2[0] * t2[0] + t2[1] * t2[1]) + (t2[2] * t2[2] + t2[3] * t2[3]);
#pragma unroll
                for (int bj = 0; bj < 2; ++bj)
#pragma unroll
                    for (int n = 0; n < 2; ++n) { const f32x4 a = acc[ai][bj][m][n]; ss += (a[0] * a[0] + a[1] * a[1]) + (a[2] * a[2] + a[3] * a[3]); }
                ss += __shfl_xor(ss, 16); ss += __shfl_xor(ss, 32);
                const float rstd = 1.0f / sqrtf(ss * (1.0f / 96.0f) + 1e-6f);
                bf16_t* kr = K + row * 768 + 96 * head;
#pragma unroll
                for (int bj = 0; bj < 2; ++bj)
                    *(u32x4*)(kr + 32 * bj + 8 * fq) = pack8(acc[ai][bj][m][0] * rstd * gn[bj][0], acc[ai][bj][m][1] * rstd * gn[bj][1]);
                t1 = t1 * rstd * g1; t2 = t2 * rstd * g2;
                const f32x4 o1 = t1 * cs - t2 * sn, o2 = t1 * sn + t2 * cs;
                u32x2e p1, p2; p1.x = cvt_pk_bf16(o1[0], o1[1]); p1.y = cvt_pk_bf16(o1[2], o1[3]); p2.x = cvt_pk_bf16(o2[0], o2[1]); p2.y = cvt_pk_bf16(o2[2], o2[3]);
                *(u32x2e*)(kr + 64 + 4 * fq) = p1; *(u32x2e*)(kr + 80 + 4 * fq) = p2;
            }
    }
};
template <class Epi, class Sched, bool ALIGN_EPI = false, bool SP2 = false>
__device__ __forceinline__ void gemm_phase(PG8_LAS unsigned char* lds, const Gemm g, const Sched& S, const Epi& E) {
    const int tid = threadIdx.x, wid = __builtin_amdgcn_readfirstlane(tid >> 6), lane = tid & 63, wr = wid >> 2, wc = wid & 3, fr = lane & 15, fq = lane >> 4;
    const int K = g.K, nt = K / BK;
    unsigned voffA[2], voffB[2];
#pragma unroll
    for (int i = 0; i < 2; ++i) { int R, C; stage_rc(tid * 16 + i * 8192, R, C); const int Rb = Epi::PERM ? ((R & ~31) + perm32(R & 31)) : R;
        voffA[i] = (unsigned)(R * K + C) * 2u; voffB[i] = (unsigned)(Rb * K + C) * 2u; }
    const size_t kstep = (size_t)(BK * 2);
    const size_t hstep = (size_t)HALF * K * 2;
    const size_t tstep = 2 * hstep;
    const unsigned ldsw = (unsigned)wid * 1024u;
    const int aoff = lds_byte(wr * 64 + fr, fq * 8), boff = lds_byte(wc * 32 + fr, fq * 8);
#define PG8_SA(b, h) (((b) * 2 + (h)) * HTB)
#define PG8_SB(b, h) ((4 + (b) * 2 + (h)) * HTB)
#define PG8_STAGE(bufoff, gbase, voff) do { _Pragma("unroll") for (int _i = 0; _i < 2; ++_i) \
        __builtin_amdgcn_global_load_lds((const unsigned*)((const char*)(gbase) + (voff)[_i]), (PG8_LAS unsigned*)(lds + (bufoff) + ldsw + _i * 8192), 16, 0, 0); } while (0)
#define PG8_LDA(dst, b, h) do { _Pragma("unroll") for (int m = 0; m < 4; ++m) _Pragma("unroll") for (int k = 0; k < 2; ++k) dst[m][k] = *(const PG8_LAS bf16x8*)(lds + PG8_SA(b, h) + aoff + m * 2048 + k * 1024); } while (0)
#define PG8_LDB(dst, b, h) do { _Pragma("unroll") for (int n = 0; n < 2; ++n) _Pragma("unroll") for (int k = 0; k < 2; ++k) dst[n][k] = *(const PG8_LAS bf16x8*)(lds + PG8_SB(b, h) + boff + n * 2048 + k * 1024); } while (0)
#define PG8_MMA(ai, bj, At, Bt) do { __builtin_amdgcn_s_setprio(1); _Pragma("unroll") for (int m = 0; m < 4; ++m) _Pragma("unroll") for (int n = 0; n < 2; ++n) _Pragma("unroll") for (int k = 0; k < 2; ++k) \
        acc[ai][bj][m][n] = __builtin_amdgcn_mfma_f32_16x16x32_bf16(Bt[n][k], At[m][k], acc[ai][bj][m][n], 0, 0, 0); __builtin_amdgcn_s_setprio(0); } while (0)
#define PG8_WAIT_V(n) asm volatile("s_waitcnt vmcnt(" #n ")" ::: "memory")
#define PG8_WAIT_L(n) asm volatile("s_waitcnt lgkmcnt(" #n ")" ::: "memory")
#define PG8_BAR __builtin_amdgcn_s_barrier()
#define PG8_SCHED __builtin_amdgcn_sched_barrier(0)
    Unit cur, nxt; int ui = 0;
    if (!S.next(0, cur)) return;
    f32x4 acc[2][2][4][2];
#pragma unroll
    for (int a = 0; a < 2; ++a)
#pragma unroll
        for (int b = 0; b < 2; ++b)
#pragma unroll
            for (int m = 0; m < 4; ++m)
#pragma unroll
                for (int n = 0; n < 2; ++n) acc[a][b][m][n] = (f32x4){0.f, 0.f, 0.f, 0.f};
    bf16x8 At[4][2], B0[2][2], B1[2][2];
    const char* cA = (const char*)g.A + (size_t)cur.pm * tstep; const char* cB = (const char*)g.Bt + (size_t)cur.pn * tstep;
    S.a_ready(cur);
    if constexpr (SP2) {
        PG8_STAGE(PG8_SB(0, 0), cB, voffB); PG8_STAGE(PG8_SB(0, 1), cB + hstep, voffB); PG8_STAGE(PG8_SA(0, 0), cA, voffA); PG8_STAGE(PG8_SA(0, 1), cA + hstep, voffA);
        if (wr == 1) PG8_BAR;
        PG8_WAIT_V(2); PG8_BAR;
        PG8_STAGE(PG8_SB(1, 0), cB + kstep, voffB); PG8_STAGE(PG8_SA(1, 0), cA + kstep, voffA); PG8_STAGE(PG8_SB(1, 1), cB + hstep + kstep, voffB);
        PG8_WAIT_V(6); PG8_BAR;
    } else {
        PG8_STAGE(PG8_SB(0, 0), cB, voffB); PG8_STAGE(PG8_SA(0, 0), cA, voffA); PG8_STAGE(PG8_SB(0, 1), cB + hstep, voffB); PG8_STAGE(PG8_SA(0, 1), cA + hstep, voffA);
        if (wr == 1) PG8_BAR;
        PG8_WAIT_V(4); PG8_BAR;
        PG8_STAGE(PG8_SB(1, 0), cB + kstep, voffB); PG8_STAGE(PG8_SA(1, 0), cA + kstep, voffA); PG8_STAGE(PG8_SB(1, 1), cB + hstep + kstep, voffB);
        PG8_WAIT_V(6); PG8_BAR;
    }
    for (;;) {
        const bool has_next = S.next(ui + 1, nxt);
        const char* nA = has_next ? (const char*)g.A + (size_t)nxt.pm * tstep : cA; const char* nB = has_next ? (const char*)g.Bt + (size_t)nxt.pn * tstep : cB;
_Pragma("unroll 1")
        for (int t = 0; t < nt; t += 2) {
            const bool last = (t == nt - 2);
            const char* a1 = cA + (size_t)(t + 1) * kstep;
            const char* a2 = last ? nA : cA + (size_t)(t + 2) * kstep; const char* b2 = last ? nB : cB + (size_t)(t + 2) * kstep;
            const char* a3 = a2 + kstep; const char* b3 = b2 + kstep;
            if (last && has_next) S.a_ready(nxt);
            if constexpr (SP2) {
            PG8_LDB(B0, 0, 0); PG8_LDB(B1, 0, 1); PG8_SCHED; PG8_LDA(At, 0, 0); PG8_STAGE(PG8_SA(1, 1), a1 + hstep, voffA);
            PG8_WAIT_V(8); PG8_WAIT_L(0); PG8_BAR; PG8_MMA(0, 0, At, B0); PG8_MMA(0, 1, At, B1); PG8_BAR; PG8_SCHED;
            PG8_LDA(At, 0, 1); PG8_STAGE(PG8_SB(0, 0), b2, voffB); PG8_STAGE(PG8_SB(0, 1), b2 + hstep, voffB); PG8_STAGE(PG8_SA(0, 0), a2, voffA);
            PG8_WAIT_V(8); PG8_WAIT_L(0); PG8_BAR; PG8_MMA(1, 0, At, B0); PG8_MMA(1, 1, At, B1); PG8_BAR; PG8_SCHED;
            PG8_LDB(B0, 1, 0); PG8_LDB(B1, 1, 1); PG8_SCHED; PG8_LDA(At, 1, 0); PG8_STAGE(PG8_SA(0, 1), a2 + hstep, voffA);
            PG8_WAIT_V(8); PG8_WAIT_L(0); PG8_BAR; PG8_MMA(0, 0, At, B0); PG8_MMA(0, 1, At, B1); PG8_BAR; PG8_SCHED;
            PG8_LDA(At, 1, 1); PG8_STAGE(PG8_SB(1, 0), b3, voffB); PG8_STAGE(PG8_SB(1, 1), b3 + hstep, voffB); PG8_STAGE(PG8_SA(1, 0), a3, voffA);
            PG8_WAIT_V(8); PG8_WAIT_L(0); PG8_BAR; PG8_MMA(1, 0, At, B0); PG8_MMA(1, 1, At, B1); PG8_BAR; PG8_SCHED;
            } else {
            PG8_LDB(B0, 0, 0); PG8_SCHED; PG8_LDA(At, 0, 0); PG8_STAGE(PG8_SA(1, 1), a1 + hstep, voffA);
            PG8_WAIT_L(8); PG8_BAR; PG8_WAIT_L(0); PG8_MMA(0, 0, At, B0); PG8_BAR; PG8_SCHED;
            PG8_LDB(B1, 0, 1); PG8_STAGE(PG8_SB(0, 0), b2, voffB);
            PG8_BAR; PG8_WAIT_L(0); PG8_MMA(0, 1, At, B1); PG8_BAR;
            PG8_LDA(At, 0, 1); PG8_STAGE(PG8_SA(0, 0), a2, voffA);
            PG8_BAR; PG8_WAIT_L(0); PG8_MMA(1, 0, At, B0); PG8_BAR; PG8_SCHED;
            PG8_STAGE(PG8_SB(0, 1), b2 + hstep, voffB);
            PG8_WAIT_V(6); PG8_BAR; PG8_MMA(1, 1, At, B1); PG8_BAR;
            PG8_LDB(B0, 1, 0); PG8_SCHED; PG8_LDA(At, 1, 0); PG8_STAGE(PG8_SA(0, 1), a2 + hstep, voffA);
            PG8_WAIT_L(8); PG8_BAR; PG8_WAIT_L(0); PG8_MMA(0, 0, At, B0); PG8_BAR; PG8_SCHED;
            PG8_LDB(B1, 1, 1); PG8_STAGE(PG8_SB(1, 0), b3, voffB);
            PG8_BAR; PG8_WAIT_L(0); PG8_MMA(0, 1, At, B1); PG8_BAR;
            PG8_LDA(At, 1, 1); PG8_STAGE(PG8_SA(1, 0), a3, voffA);
            PG8_BAR; PG8_WAIT_L(0); PG8_MMA(1, 0, At, B0); PG8_BAR; PG8_SCHED;
            PG8_STAGE(PG8_SB(1, 1), b3 + hstep, voffB);
            PG8_WAIT_V(6); PG8_BAR; PG8_MMA(1, 1, At, B1); PG8_BAR;
            }
        }
        if constexpr (ALIGN_EPI) { if (wr == 0) PG8_BAR; }
        if constexpr (!Epi::AFTER_DRAIN) { E(acc, cur, wr, wc, fr, fq); S.done(cur); }
        if (!has_next) break;
#pragma unroll
        for (int a = 0; a < 2; ++a)
#pragma unroll
            for (int b = 0; b < 2; ++b)
#pragma unroll
                for (int m = 0; m < 4; ++m)
#pragma unroll
                    for (int n = 0; n < 2; ++n) acc[a][b][m][n] = (f32x4){0.f, 0.f, 0.f, 0.f};
        cur = nxt; cA = nA; cB = nB; ++ui;
        if constexpr (ALIGN_EPI) { if (wr == 1) PG8_BAR; }
    }
    PG8_WAIT_V(0);
    if constexpr (!ALIGN_EPI) { if (wr == 0) PG8_BAR; }
    PG8_BAR;
    if constexpr (Epi::AFTER_DRAIN) { E.fused(acc, cur, wr, wc, fr, fq, lds, wid, lane); S.done(cur); }
#undef PG8_SA
#undef PG8_SB
#undef PG8_STAGE
#undef PG8_LDA
#undef PG8_LDB
#undef PG8_MMA
#undef PG8_WAIT_V
#undef PG8_WAIT_L
#undef PG8_BAR
#undef PG8_SCHED
}
}

#define LAS __attribute__((address_space(3)))
typedef unsigned short bf16;
typedef unsigned u32x4 __attribute__((ext_vector_type(4)));
typedef unsigned u32x2 __attribute__((ext_vector_type(2)));
typedef float f32x4 __attribute__((ext_vector_type(4)));
typedef float f32x16 __attribute__((ext_vector_type(16)));
typedef short bf16x8 __attribute__((ext_vector_type(8)));
typedef short s16x4 __attribute__((ext_vector_type(4)));
constexpr int NWAVES = 8;
typedef unsigned short bf16_fwd_unused;
#define XB_TMO      128
#define XB_XCNT(j)  (256  + 64 * (j))
#define XB_XSUB(j)  (1280 + 64 * (j))
#define XB_XGEN(j)  (2304 + 64 * (j))
#define XB_TOP      3328
#define XB_TOPGEN   3392
#define XCD_BAR_WORDS 3456
#define XB_SPIN_CAP (1u << 18)

__device__ __forceinline__ unsigned xb_ld(unsigned* p)              { return __hip_atomic_load(p, __ATOMIC_RELAXED, __HIP_MEMORY_SCOPE_AGENT); }
__device__ __forceinline__ unsigned xb_add(unsigned* p, unsigned v) { return __hip_atomic_fetch_add(p, v, __ATOMIC_RELAXED, __HIP_MEMORY_SCOPE_AGENT); }
__device__ __forceinline__ unsigned xb_xcc_id() { return (unsigned)__builtin_amdgcn_s_getreg((3 << 11) | 20) & 0xFu; }
#define XB_SPIN(cond, bar) do { unsigned _sp = 0; while (cond) { __builtin_amdgcn_s_sleep(1); \
    if ((++_sp & 255u) == 0u) { if (xb_ld(&(bar)[XB_TMO])) break; if (_sp > XB_SPIN_CAP) { atomicAdd(&(bar)[XB_TMO], 1u); break; } } } } while (0)

struct XcdBarrier {
    unsigned* bar; unsigned x;
    volatile LAS unsigned* st;
};

__device__ __forceinline__ XcdBarrier xcd_barrier_post(unsigned* bar, volatile LAS unsigned* st) {
    XcdBarrier b; b.bar = bar; b.x = xb_xcc_id(); b.st = st;
    if (threadIdx.x == 0) (void)xb_add(&bar[XB_XCNT(b.x)], 1u);
    return b;
}
__device__ __forceinline__ void xcd_barrier_complete(unsigned* bar, unsigned x, unsigned& nloc, unsigned& nx) {
    const unsigned G = gridDim.x * gridDim.y * gridDim.z;
    unsigned sum, cnt, mine, sp = 0u;
    for (;;) {
        sum = 0u; cnt = 0u; mine = 0u;
#pragma unroll
        for (unsigned j = 0; j < 16; ++j) { const unsigned c = xb_ld(&bar[XB_XCNT(j)]); sum += c; cnt += (c > 0u) ? 1u : 0u; mine = (j == x) ? c : mine; }
        if (sum == G) break;
        __builtin_amdgcn_s_sleep(1);
        if ((++sp & 255u) == 0u) { if (xb_ld(&bar[XB_TMO])) break; if (sp > XB_SPIN_CAP) { atomicAdd(&bar[XB_TMO], 1u); break; } }
    }
    nloc = mine > 0u ? mine : 1u; nx = cnt > 0u ? cnt : 1u;
}

__device__ __forceinline__ void xcd_barrier(const XcdBarrier& b) {
    asm volatile("s_waitcnt vmcnt(0)" ::: "memory");
    __syncthreads();
    if (threadIdx.x == 0) {
        unsigned* bar = b.bar;
        __builtin_amdgcn_s_waitcnt(0);
        unsigned nloc = b.st[0], nx = b.st[1];
        if (nloc == 0u) { xcd_barrier_complete(bar, b.x, nloc, nx); b.st[0] = nloc; b.st[1] = nx; }
        const unsigned old = xb_add(&bar[XB_XSUB(b.x)], 1u);
        const unsigned gen = old / nloc;
        if (old + 1u == (gen + 1u) * nloc) {
            __builtin_amdgcn_fence(__ATOMIC_RELEASE, "agent");
            asm volatile("s_waitcnt vmcnt(0)" ::: "memory");
            const unsigned og = xb_add(&bar[XB_TOP], 1u);
            const unsigned tg = og / nx;
            if (og + 1u == (tg + 1u) * nx) xb_add(&bar[XB_TOPGEN], 1u);
            else XB_SPIN(xb_ld(&bar[XB_TOPGEN]) == tg, bar);
            __builtin_amdgcn_fence(__ATOMIC_ACQUIRE, "agent");
            xb_add(&bar[XB_XGEN(b.x)], 1u);
            asm volatile("s_waitcnt vmcnt(0)" ::: "memory");
        } else {
            XB_SPIN(xb_ld(&bar[XB_XGEN(b.x)]) == gen, bar);
            __builtin_amdgcn_fence(__ATOMIC_ACQUIRE, "agent");
            asm volatile("s_waitcnt vmcnt(0)" ::: "memory");
        }
    }
    __syncthreads();
}

constexpr int T = 32768, D = 1024, FF = 2816, SEQ = 2048, NH = 8;
constexpr int NIN = 5792, NINP = 5888;
constexpr float EPS = 1e-6f;
constexpr size_t MiB = 1u << 20;
constexpr size_t WS_W1GU = 1 * MiB;
constexpr size_t WS_W1D = WS_W1GU + 11 * MiB;
constexpr size_t WS_WIN = WS_W1D + 6 * MiB;
constexpr size_t WS_WUQ = WS_WIN + 12 * MiB;
constexpr size_t WS_WUK = WS_WUQ + 1 * MiB;
constexpr size_t WS_WUV = WS_WUK + 1 * MiB;
constexpr size_t WS_WPA = WS_WUV + 1 * MiB;
constexpr size_t WS_WPC = WS_WPA + 1 * MiB;
constexpr size_t WS_WOUT = WS_WPC + 2 * MiB;
constexpr size_t WS_W2GU = WS_WOUT + 2 * MiB;
constexpr size_t WS_W2D = WS_W2GU + 11 * MiB;
static_assert(WS_W2D + 6 * MiB <= 56 * MiB, "weights");
constexpr size_t WS_XN = 56 * MiB;
constexpr size_t WS_ZB = WS_XN;
constexpr size_t WS_H = 120 * MiB;
constexpr size_t WS_U = 120 * MiB, WS_GB = 184 * MiB, WS_LAT = 248 * MiB;
constexpr size_t WS_GATES = 296 * MiB;
constexpr size_t WS_QN = 424 * MiB, WS_CKV = 448 * MiB;
constexpr size_t WS_Q = 120 * MiB, WS_K = 168 * MiB, WS_VT = 216 * MiB;
constexpr size_t WS_AO = 464 * MiB;
constexpr size_t WS_MG = 120 * MiB;
constexpr size_t WS_CS = 496 * MiB;
constexpr size_t WS_END = 500 * MiB;
constexpr int LDS_BYTES = 147456;

__device__ __forceinline__ unsigned f2bf(float f) { unsigned u = __builtin_bit_cast(unsigned, f); return (u + 0x7fffu + ((u >> 16) & 1u)) >> 16; }
__device__ __forceinline__ unsigned pk2(float lo, float hi) { return pg8::cvt_pk_bf16(lo, hi); }
__device__ __forceinline__ float bflo(unsigned w) { return __uint_as_float(w << 16); }
__device__ __forceinline__ float bfhi(unsigned w) { return __uint_as_float(w & 0xffff0000u); }
__device__ __forceinline__ float wave_sum(float v) {
#pragma unroll
    for (int o = 1; o < 64; o <<= 1) v += __shfl_xor(v, o);
    return v;
}
#define LDS_WAIT() asm volatile("s_waitcnt lgkmcnt(0)" ::: "memory")

enum { MAP_ID = 0, MAP_GATE = 1, MAP_UP = 2, MAP_WIN = 3, MAP_UK = 4 };
__device__ __forceinline__ int map_row(int mode, int n0) {
    if (mode == MAP_GATE) return 256 * (n0 >> 7) + (n0 & 127);
    if (mode == MAP_UP) return 256 * (n0 >> 7) + 128 + (n0 & 127);
    if (mode == MAP_UK) { const int head = n0 >> 6, dim = n0 & 63; return 256 * (head >> 2) + 128 * (dim >> 5) + 32 * (head & 3) + (dim & 31); }
    if (mode == MAP_WIN) {
        if (n0 < 672) return n0;
        if (n0 < 1696) { const int j = n0 - 672; return 256 * (3 + (j >> 7)) + (j & 127); }
        if (n0 < 2720) { return 256 * 11 + (n0 - 1696); }
        if (n0 < 3744) { const int j = n0 - 2720; return 256 * (3 + (j >> 7)) + 128 + (j & 127); }
        return 256 * 15 + (n0 - 3744);
    }
    return n0;
}
__device__ __forceinline__ void p0_transpose_item(const float* W, int K, int N, bf16* WT, int mode, LAS float* scr, int item, int lane) {
    const int nblk = N / 32, kb = item / nblk, nb = item % nblk, k0 = 64 * kb, n0 = 32 * nb;
    const int r0 = map_row(mode, n0);
    float wv[32];
    { const float* wp = W + (size_t)(k0 + (lane >> 5)) * N + n0 + (lane & 31);
#pragma unroll
      for (int i = 0; i < 32; ++i) wv[i] = wp[(size_t)(2 * i) * N]; }
#pragma unroll
    for (int i = 0; i < 32; ++i) scr[(2 * i + (lane >> 5)) * 33 + (lane & 31)] = wv[i];
    LDS_WAIT(); asm volatile("" ::: "memory");
    const int c = lane & 7;
#pragma unroll
    for (int j = 0; j < 4; ++j) { const int n = (lane >> 3) + 8 * j; const LAS float* s = scr + (8 * c) * 33 + n;
        u32x4 o; o.x = pk2(s[0 * 33], s[1 * 33]); o.y = pk2(s[2 * 33], s[3 * 33]); o.z = pk2(s[4 * 33], s[5 * 33]); o.w = pk2(s[6 * 33], s[7 * 33]);
        *(u32x4*)(WT + (size_t)(r0 + n) * K + k0 + 8 * c) = o; }
    LDS_WAIT(); asm volatile("" ::: "memory");
}
__device__ __forceinline__ void rms_row_to_bf16(const float* xrow, const float* gain, bf16* orow, int lane) {
    const f32x4* xr = (const f32x4*)xrow + lane; const f32x4* gr = (const f32x4*)gain + lane;
    f32x4 v[4]; float s = 0.f;
#pragma unroll
    for (int j = 0; j < 4; ++j) { v[j] = xr[64 * j]; s += (v[j].x * v[j].x + v[j].y * v[j].y) + (v[j].z * v[j].z + v[j].w * v[j].w); }
    const float rstd = 1.0f / sqrtf(wave_sum(s) * (1.f / 1024.f) + EPS);
    u32x2* o8 = (u32x2*)orow + lane;
#pragma unroll
    for (int j = 0; j < 4; ++j) { const f32x4 g = gr[64 * j]; u32x2 w; w.x = pk2(v[j].x * rstd * g.x, v[j].y * rstd * g.y); w.y = pk2(v[j].z * rstd * g.z, v[j].w * rstd * g.w); o8[64 * j] = w; }
}

__device__ __forceinline__ void rms_rows2_to_bf16(const float* xa, const float* xb, const float* gain, bf16* oa, bf16* ob, int lane) {
    const f32x4* xr0 = (const f32x4*)xa + lane; const f32x4* xr1 = (const f32x4*)xb + lane; const f32x4* gr = (const f32x4*)gain + lane;
    f32x4 v0[4], v1[4]; float s0 = 0.f, s1 = 0.f;
#pragma unroll
    for (int j = 0; j < 4; ++j) { v0[j] = xr0[64 * j]; v1[j] = xr1[64 * j]; }
#pragma unroll
    for (int j = 0; j < 4; ++j) { s0 += (v0[j].x * v0[j].x + v0[j].y * v0[j].y) + (v0[j].z * v0[j].z + v0[j].w * v0[j].w); s1 += (v1[j].x * v1[j].x + v1[j].y * v1[j].y) + (v1[j].z * v1[j].z + v1[j].w * v1[j].w); }
#pragma unroll
    for (int o = 1; o < 64; o <<= 1) { s0 += __shfl_xor(s0, o); s1 += __shfl_xor(s1, o); }
    const float r0 = 1.0f / sqrtf(s0 * (1.f / 1024.f) + EPS), r1 = 1.0f / sqrtf(s1 * (1.f / 1024.f) + EPS);
    u32x2* o0 = (u32x2*)oa + lane; u32x2* o1 = (u32x2*)ob + lane;
#pragma unroll
    for (int j = 0; j < 4; ++j) { const f32x4 g = gr[64 * j]; u32x2 w; w.x = pk2(v0[j].x * r0 * g.x, v0[j].y * r0 * g.y); w.y = pk2(v0[j].z * r0 * g.z, v0[j].w * r0 * g.w); o0[64 * j] = w;
        w.x = pk2(v1[j].x * r1 * g.x, v1[j].y * r1 * g.y); w.y = pk2(v1[j].z * r1 * g.z, v1[j].w * r1 * g.w); o1[64 * j] = w; }
}
__device__ __forceinline__ void rms_pass(const float* src, const float* gain, bf16* dst, int gw, int NGW, int lane) {
    int m = gw;
    for (; m + NGW < T; m += 2 * NGW) rms_rows2_to_bf16(src + (size_t)m * D, src + (size_t)(m + NGW) * D, gain, dst + (size_t)m * D, dst + (size_t)(m + NGW) * D, lane);
    if (m < T) rms_row_to_bf16(src + (size_t)m * D, gain, dst + (size_t)m * D, lane);
}

namespace att {
constexpr int QP = 768, OP = 512;
constexpr int KSTR = 208, VSTR = 144, OSTR = 144;
constexpr int KBUF = 64 * KSTR, VBUF = 64 * VSTR;
constexpr int L_K = 0, L_V = 2 * KBUF, L_OST = L_V + 2 * VBUF, L_END = L_OST + 8 * 32 * OSTR;
static_assert(L_END <= 131072, "attention LDS");
__device__ __forceinline__ int crow(int r, int hi) { return (r & 3) + 8 * (r >> 2) + 4 * hi; }
__device__ __forceinline__ void attn_unit(int b, int h, int qb, const bf16* Q, const bf16* K, const bf16* VT, bf16* O, const float* qhn, const float* CS, LAS unsigned char* lds) {
    const int tid = threadIdx.x, lane = tid & 63, r32 = lane & 31, hi = lane >> 5; const int wid = __builtin_amdgcn_readfirstlane(tid >> 6);
    const size_t rowbase = (size_t)b * SEQ; const int q0 = qb * 256, qw = q0 + wid * 32;
    bf16x8 qf[6];
    {
      const size_t qrow = rowbase + qw + r32;
      const bf16* qp = Q + qrow * QP + h * 96 + hi * 8;
      u32x4 raw[6];
#pragma unroll
      for (int ks = 0; ks < 6; ++ks) raw[ks] = *(const u32x4*)(qp + ks * 16);
      const f32x4 c0 = *(const f32x4*)(CS + qrow * 32 + 8 * hi), c1 = *(const f32x4*)(CS + qrow * 32 + 8 * hi + 4), s0 = *(const f32x4*)(CS + qrow * 32 + 16 + 8 * hi), s1 = *(const f32x4*)(CS + qrow * 32 + 16 + 8 * hi + 4);
      float v[6][8]; float ss = 0.f;
#pragma unroll
      for (int ks = 0; ks < 6; ++ks)
#pragma unroll
          for (int j = 0; j < 4; ++j) { v[ks][2 * j] = bflo(raw[ks][j]); v[ks][2 * j + 1] = bfhi(raw[ks][j]); ss += v[ks][2 * j] * v[ks][2 * j] + v[ks][2 * j + 1] * v[ks][2 * j + 1]; }
      ss += __shfl_xor(ss, 32);
      const float rstd = 1.0f / sqrtf(ss * (1.f / 96.f) + EPS);
#pragma unroll
      for (int ks = 0; ks < 6; ++ks) { const f32x4 g0 = *(const f32x4*)(qhn + 16 * ks + 8 * hi), g1 = *(const f32x4*)(qhn + 16 * ks + 8 * hi + 4);
#pragma unroll
          for (int j = 0; j < 4; ++j) { v[ks][j] *= rstd * g0[j]; v[ks][4 + j] *= rstd * g1[j]; } }
#pragma unroll
      for (int j = 0; j < 8; ++j) { const float cc = j < 4 ? c0[j & 3] : c1[j & 3], sn = j < 4 ? s0[j & 3] : s1[j & 3]; const float t1 = v[4][j], t2 = v[5][j]; v[4][j] = t1 * cc - t2 * sn; v[5][j] = t1 * sn + t2 * cc; }
      const float QSCALE = 0.10206207261596577f * 1.4426950408889634f;
#pragma unroll
      for (int ks = 0; ks < 6; ++ks) { u32x4 w;
#pragma unroll
          for (int j = 0; j < 4; ++j) w[j] = pk2(v[ks][2 * j] * QSCALE, v[ks][2 * j + 1] * QSCALE);
          qf[ks] = __builtin_bit_cast(bf16x8, w); } }
    f32x16 o0, o1, negm;
#pragma unroll
    for (int r = 0; r < 16; ++r) { o0[r] = 0.f; o1[r] = 0.f; negm[r] = 0.f; }
    float m_ref = 0.f, l_run = 0.f;
    const int NT = (q0 + 256) / 64;
    const int kk0 = tid / 12, kp0 = tid % 12, kk1 = (512 + tid) / 12, kp1 = (512 + tid) % 12;
    const bf16* Kg = K + rowbase * QP + h * 96;
    const bf16* Vg = VT + (size_t)(h * 64 + (tid >> 3)) * T + rowbase + (tid & 7) * 8;
    u32x4 kr0A, kr1A = (u32x4){0u, 0u, 0u, 0u}, vrA, kr0B, kr1B = (u32x4){0u, 0u, 0u, 0u}, vrB;
#define ATT_GLOAD(S, t) do { kr0##S = *(const u32x4*)(Kg + (size_t)((t) * 64 + kk0) * QP + kp0 * 8); if (tid < 256) kr1##S = *(const u32x4*)(Kg + (size_t)((t) * 64 + kk1) * QP + kp1 * 8); vr##S = *(const u32x4*)(Vg + (t) * 64); } while (0)
#define ATT_LSTORE(S, buf) do { *(LAS u32x4*)(lds + L_K + (buf) * KBUF + kk0 * KSTR + kp0 * 16) = kr0##S; if (tid < 256) *(LAS u32x4*)(lds + L_K + (buf) * KBUF + kk1 * KSTR + kp1 * 16) = kr1##S; \
        *(LAS u32x4*)(lds + L_V + (buf) * VBUF + (tid >> 3) * VSTR + (tid & 7) * 16) = vr##S; } while (0)
#define ATT_TILE(t, buf) do { const int k0 = (t) * 64; \
        if (k0 <= qw + 31) { \
            const LAS unsigned char* kb = lds + L_K + (buf) * KBUF + r32 * KSTR + hi * 16; \
            f32x16 p0, p1; \
            { const bf16x8 a0 = *(const LAS bf16x8*)(kb), a1 = *(const LAS bf16x8*)(kb + 32 * KSTR); \
              p0 = __builtin_amdgcn_mfma_f32_32x32x16_bf16(a0, qf[0], negm, 0, 0, 0); p1 = __builtin_amdgcn_mfma_f32_32x32x16_bf16(a1, qf[0], negm, 0, 0, 0); } \
            _Pragma("unroll") for (int ks = 1; ks < 6; ++ks) { \
                const bf16x8 a0 = *(const LAS bf16x8*)(kb + ks * 32), a1 = *(const LAS bf16x8*)(kb + 32 * KSTR + ks * 32); \
                p0 = __builtin_amdgcn_mfma_f32_32x32x16_bf16(a0, qf[ks], p0, 0, 0, 0); p1 = __builtin_amdgcn_mfma_f32_32x32x16_bf16(a1, qf[ks], p1, 0, 0, 0); } \
            if (k0 + 63 > qw) { const int q = qw + r32; \
                _Pragma("unroll") for (int r = 0; r < 16; ++r) { const int key = k0 + crow(r, hi); if (key > q) p0[r] = -1e30f; if (key + 32 > q) p1[r] = -1e30f; } } \
            float mxa = __builtin_fmaxf(__builtin_fmaxf(p0[0], p0[1]), p1[0]), mxb = __builtin_fmaxf(__builtin_fmaxf(p0[2], p0[3]), p1[1]); mxa = __builtin_fmaxf(__builtin_fmaxf(mxa, p1[2]), p1[3]); \
            _Pragma("unroll") for (int r = 4; r < 16; r += 4) { mxa = __builtin_fmaxf(__builtin_fmaxf(mxa, p0[r]), p0[r + 1]); mxb = __builtin_fmaxf(__builtin_fmaxf(mxb, p0[r + 2]), p0[r + 3]); \
                mxa = __builtin_fmaxf(__builtin_fmaxf(mxa, p1[r]), p1[r + 1]); mxb = __builtin_fmaxf(__builtin_fmaxf(mxb, p1[r + 2]), p1[r + 3]); } \
            float mx = __builtin_fmaxf(mxa, mxb); mx = __builtin_fmaxf(mx, __shfl_xor(mx, 32)); \
            if (__any(mx > 8.0f)) { const float dl = __builtin_fmaxf(mx, 0.f); m_ref += dl; const float al = __builtin_amdgcn_exp2f(-dl); l_run *= al; \
                _Pragma("unroll") for (int r = 0; r < 16; ++r) { p0[r] -= dl; p1[r] -= dl; o0[r] *= al; o1[r] *= al; negm[r] = -m_ref; } } \
            float rs0 = 0.f, rs1 = 0.f; \
            _Pragma("unroll") for (int r = 0; r < 16; ++r) { p0[r] = __builtin_amdgcn_exp2f(p0[r]); p1[r] = __builtin_amdgcn_exp2f(p1[r]); rs0 += p0[r]; rs1 += p1[r]; } \
            l_run += rs0 + rs1; \
            u32x4 pw[4]; \
            _Pragma("unroll") for (int j = 0; j < 4; ++j) { pw[0][j] = pk2(p0[2 * j], p0[2 * j + 1]); pw[1][j] = pk2(p0[8 + 2 * j], p0[8 + 2 * j + 1]); pw[2][j] = pk2(p1[2 * j], p1[2 * j + 1]); pw[3][j] = pk2(p1[8 + 2 * j], p1[8 + 2 * j + 1]); } \
            const LAS unsigned char* vb = lds + L_V + (buf) * VBUF + r32 * VSTR + hi * 8; \
            _Pragma("unroll") for (int ks = 0; ks < 4; ++ks) { \
                const bf16x8 pf = __builtin_bit_cast(bf16x8, pw[ks]); \
                { const s16x4 lo = *(const LAS s16x4*)(vb + ks * 32), hh = *(const LAS s16x4*)(vb + ks * 32 + 16); \
                  const bf16x8 vf = (bf16x8){lo[0], lo[1], lo[2], lo[3], hh[0], hh[1], hh[2], hh[3]}; \
                  o0 = __builtin_amdgcn_mfma_f32_32x32x16_bf16(vf, pf, o0, 0, 0, 0); } \
                { const s16x4 lo = *(const LAS s16x4*)(vb + 32 * VSTR + ks * 32), hh = *(const LAS s16x4*)(vb + 32 * VSTR + ks * 32 + 16); \
                  const bf16x8 vf = (bf16x8){lo[0], lo[1], lo[2], lo[3], hh[0], hh[1], hh[2], hh[3]}; \
                  o1 = __builtin_amdgcn_mfma_f32_32x32x16_bf16(vf, pf, o1, 0, 0, 0); } } \
        } } while (0)
    ATT_GLOAD(A, 0); ATT_LSTORE(A, 0); ATT_GLOAD(A, 1); ATT_GLOAD(B, 2); __syncthreads();
    for (int t = 0; t < NT; t += 2) {
        ATT_TILE(t, 0);
        ATT_LSTORE(A, 1);
        if (t + 3 < NT) ATT_GLOAD(A, t + 3);
        __syncthreads();
        ATT_TILE(t + 1, 1);
        if (t + 2 < NT) ATT_LSTORE(B, 0);
        if (t + 4 < NT) ATT_GLOAD(B, t + 4);
        __syncthreads();
    }
#undef ATT_GLOAD
#undef ATT_LSTORE
#undef ATT_TILE
    const float l = l_run + __shfl_xor(l_run, 32), inv = 1.0f / l;
    LAS unsigned char* stg = lds + L_OST + wid * (32 * OSTR);
#pragma unroll
    for (int r = 0; r < 16; ++r) { const int d = crow(r, hi);
        *(LAS unsigned short*)(stg + r32 * OSTR + d * 2) = (unsigned short)f2bf(o0[r] * inv);
        *(LAS unsigned short*)(stg + r32 * OSTR + (32 + d) * 2) = (unsigned short)f2bf(o1[r] * inv); }
    LDS_WAIT(); asm volatile("" ::: "memory");
    bf16* Ow = O + (rowbase + qw) * OP + h * 64;
#pragma unroll
    for (int i = 0; i < 4; ++i) { const int row = i * 8 + (lane >> 3), ch = lane & 7; const u32x4 v = *(const LAS u32x4*)(stg + row * OSTR + ch * 16); *(u32x4*)(Ow + (size_t)row * OP + ch * 8) = v; }
    LDS_WAIT(); asm volatile("" ::: "memory");
}
}

constexpr int NPH = 14;
struct Args { const void* in[24]; float* out; unsigned char* ws; int ph_lo, ph_hi; };
static_assert(sizeof(Args) == 24 * 8 + 8 + 8 + 8, "Args has no padding");

__global__ void __launch_bounds__(NWAVES * 64, 2) fwd_kernel(Args args) {
    extern __shared__ __attribute__((aligned(16))) unsigned char lds_raw[];
    LAS unsigned char* lds = (LAS unsigned char*)lds_raw;
    cg::grid_group grid = cg::this_grid();
    const int tid = threadIdx.x, lane = tid & 63, wave = __builtin_amdgcn_readfirstlane(tid >> 6);
    const int G = gridDim.x, bx = blockIdx.x;
    const int gw = bx * NWAVES + wave, NGW = G * NWAVES;
    unsigned char* ws = args.ws;
    const float* x = (const float*)args.in[0]; const int* positions = (const int*)args.in[1];
    float* out = args.out;
    bf16* W1GU = (bf16*)(ws + WS_W1GU); bf16* W1D = (bf16*)(ws + WS_W1D); bf16* WIN = (bf16*)(ws + WS_WIN); bf16* WUQ = (bf16*)(ws + WS_WUQ);
    bf16* WUK = (bf16*)(ws + WS_WUK); bf16* WUV = (bf16*)(ws + WS_WUV); bf16* WPA = (bf16*)(ws + WS_WPA); bf16* WPC = (bf16*)(ws + WS_WPC);
    bf16* WOUT = (bf16*)(ws + WS_WOUT); bf16* W2GU = (bf16*)(ws + WS_W2GU); bf16* W2D = (bf16*)(ws + WS_W2D);
    bf16* XN = (bf16*)(ws + WS_XN); bf16* ZB = (bf16*)(ws + WS_ZB); bf16* HB = (bf16*)(ws + WS_H); bf16* UB = (bf16*)(ws + WS_U); bf16* GBB = (bf16*)(ws + WS_GB);
    bf16* LAT = (bf16*)(ws + WS_LAT); bf16* GATES = (bf16*)(ws + WS_GATES); bf16* QN = (bf16*)(ws + WS_QN); bf16* CKV = (bf16*)(ws + WS_CKV);
    bf16* QB = (bf16*)(ws + WS_Q); bf16* KB = (bf16*)(ws + WS_K); bf16* VT = (bf16*)(ws + WS_VT); bf16* AO = (bf16*)(ws + WS_AO); bf16* MG = (bf16*)(ws + WS_MG); bf16* M1 = (bf16*)(ws + 184 * MiB); float* CS = (float*)(ws + WS_CS);
    const int lo = args.ph_lo, hi = args.ph_hi;
#ifndef PH_MASK
#define PH_MASK 0xFFFF
#endif
#define IN(k) (((PH_MASK >> (k)) & 1) && lo <= (k) && (k) < hi)
    LAS unsigned* misc = (LAS unsigned*)(lds + 131072 + 256);
    if (tid < 64) misc[tid] = 0u;
    __syncthreads();
    XcdBarrier xbar = xcd_barrier_post((unsigned*)ws, (volatile LAS unsigned*)(misc + 8));
    if (hi > NPH) grid.sync();
#define SEAM(k) do { if (IN(k) && IN((k) + 1)) xcd_barrier(xbar); } while (0)

#ifdef NANFILL
    if (lo == 0) {
        for (int i = tid; i < LDS_BYTES / 16; i += 512) *((LAS u32x4*)lds + i) = (u32x4){0x7fc07fc0u, 0x7fc07fc0u, 0x7fc07fc0u, 0x7fc07fc0u};
        __syncthreads();
        u32x4* wsv = (u32x4*)(ws + 120 * MiB);
        for (size_t i = (size_t)bx * 512 + tid; i < (size_t)(376 * MiB / 16); i += (size_t)G * 512) wsv[i] = (u32x4){0x7fc07fc0u, 0x7fc07fc0u, 0x7fc07fc0u, 0x7fc07fc0u};
    }
#endif
#ifndef REPE
#define REPE 1
#endif
    if (IN(0)) for (int repe = 0; repe < REPE; ++repe) {
        LAS float* scr = (LAS float*)(lds + wave * 16384);
        constexpr int I_G = 16 * 88, I_D = 44 * 32, I_IN = 16 * 181, I_UQ = 6 * 24, I_UK = 4 * 16, I_PA = 8 * 32, I_SQ = 16 * 32;
        constexpr int NITEMS = 2 * (2 * I_G + I_D) + I_IN + I_UQ + 2 * I_UK + I_PA + 2 * I_SQ;
        for (int it = gw; it < NITEMS; it += NGW) {
            int r = it;
            if (r < I_G) { p0_transpose_item((const float*)args.in[3], 1024, FF, W1GU, MAP_GATE, scr, r, lane); continue; } r -= I_G;
            if (r < I_G) { p0_transpose_item((const float*)args.in[4], 1024, FF, W1GU, MAP_UP, scr, r, lane); continue; } r -= I_G;
            if (r < I_D) { p0_transpose_item((const float*)args.in[5], FF, 1024, W1D, MAP_ID, scr, r, lane); continue; } r -= I_D;
            if (r < I_G) { p0_transpose_item((const float*)args.in[21], 1024, FF, W2GU, MAP_GATE, scr, r, lane); continue; } r -= I_G;
            if (r < I_G) { p0_transpose_item((const float*)args.in[22], 1024, FF, W2GU, MAP_UP, scr, r, lane); continue; } r -= I_G;
            if (r < I_D) { p0_transpose_item((const float*)args.in[23], FF, 1024, W2D, MAP_ID, scr, r, lane); continue; } r -= I_D;
            if (r < I_IN) { p0_transpose_item((const float*)args.in[7], 1024, NIN, WIN, MAP_WIN, scr, r, lane); continue; } r -= I_IN;
            if (r < I_UQ) { p0_transpose_item((const float*)args.in[10], 384, 768, WUQ, MAP_ID, scr, r, lane); continue; } r -= I_UQ;
            if (r < I_UK) { p0_transpose_item((const float*)args.in[12], 256, 512, WUK, MAP_UK, scr, r, lane); continue; } r -= I_UK;
            if (r < I_UK) { p0_transpose_item((const float*)args.in[13], 256, 512, WUV, MAP_ID, scr, r, lane); continue; } r -= I_UK;
            if (r < I_PA) { p0_transpose_item((const float*)args.in[16], 512, 1024, WPA, MAP_ID, scr, r, lane); continue; } r -= I_PA;
            if (r < I_SQ) { p0_transpose_item((const float*)args.in[18], 1024, 1024, WPC, MAP_ID, scr, r, lane); continue; } r -= I_SQ;
            p0_transpose_item((const float*)args.in[19], 1024, 1024, WOUT, MAP_ID, scr, r, lane);
        }
        for (int i = bx * 512 + tid; i < 12288; i += G * 512) *((u32x4*)(WIN + (size_t)672 * 1024) + i) = (u32x4){0u, 0u, 0u, 0u};
        rms_pass(x, (const float*)args.in[2], XN, gw, NGW, lane);
    }
    SEAM(0);
#ifndef REP1
#define REP1 1
#endif
    if (IN(1)) for (int rep1 = 0; rep1 < REP1; ++rep1) {
        pg8::Gemm g{XN, W1GU, T, 2 * FF, D}; pg8::StaticOrder S; S.init(T, 2 * FF, G, bx);
        pg8::EpiSwiglu E{HB, FF};
        pg8::gemm_phase<pg8::EpiSwiglu, pg8::StaticOrder, true, true>(lds, g, S, E);
    }
    SEAM(1);
    if (IN(2)) {
        pg8::Gemm g{HB, W1D, T, D, FF}; pg8::StaticOrder S; S.init(T, D, G, bx);
        pg8::EpiResF32 E{x, out, D, 0.5f};
        pg8::gemm_phase<pg8::EpiResF32, pg8::StaticOrder, true, true>(lds, g, S, E);
    }
    SEAM(2);
    if (IN(3)) for (int repe = 0; repe < REPE; ++repe) rms_pass(out, (const float*)args.in[6], XN, gw, NGW, lane);
    SEAM(3);
    if (IN(4)) {
        pg8::Gemm g{XN, WIN, T, NINP, D}; pg8::StaticOrder S; S.init(T, NINP, G, bx);
        pg8::EpiWin E{LAT, UB, GBB, GATES, (const float*)args.in[8]};
        pg8::gemm_phase<pg8::EpiWin, pg8::StaticOrder, true, true>(lds, g, S, E);
    }
    SEAM(4);
    if (IN(5)) for (int repe = 0; repe < REPE; ++repe) {
        const float* qg = (const float*)args.in[9]; const float* kg = (const float*)args.in[11]; const float* cw = (const float*)args.in[17];
        f32x4 cwv[2][3][2];
#pragma unroll
        for (int hh = 0; hh < 2; ++hh)
#pragma unroll
            for (int k = 0; k < 3; ++k) { cwv[hh][k][0] = *(const f32x4*)(cw + 1024 * k + 512 * hh + 8 * lane); cwv[hh][k][1] = *(const f32x4*)(cw + 1024 * k + 512 * hh + 8 * lane + 4); }
        for (int m = gw; m < T; m += NGW) {
            const bf16* lr = LAT + (size_t)m * 768;
            u32x4 qv = (u32x4){0u, 0u, 0u, 0u}, kv = (u32x4){0u, 0u, 0u, 0u};
            if (lane < 48) qv = *(const u32x4*)(lr + 8 * lane);
            if (lane < 32) kv = *(const u32x4*)(lr + 384 + 8 * lane);
            float qf[8], kf[8]; float sq = 0.f, sk = 0.f;
#pragma unroll
            for (int j = 0; j < 4; ++j) { qf[2 * j] = bflo(qv[j]); qf[2 * j + 1] = bfhi(qv[j]); kf[2 * j] = bflo(kv[j]); kf[2 * j + 1] = bfhi(kv[j]); }
#pragma unroll
            for (int j = 0; j < 8; ++j) { sq += qf[j] * qf[j]; sk += kf[j] * kf[j]; }
            const float rq = 1.0f / sqrtf(wave_sum(sq) * (1.f / 384.f) + EPS), rk = 1.0f / sqrtf(wave_sum(sk) * (1.f / 256.f) + EPS);
            if (lane < 48) { const f32x4 g0 = *(const f32x4*)(qg + 8 * lane), g1 = *(const f32x4*)(qg + 8 * lane + 4); u32x4 w;
                w.x = pk2(qf[0] * rq * g0.x, qf[1] * rq * g0.y); w.y = pk2(qf[2] * rq * g0.z, qf[3] * rq * g0.w); w.z = pk2(qf[4] * rq * g1.x, qf[5] * rq * g1.y); w.w = pk2(qf[6] * rq * g1.z, qf[7] * rq * g1.w);
                *(u32x4*)(QN + (size_t)m * 384 + 8 * lane) = w; }
            if (lane < 32) { const f32x4 g0 = *(const f32x4*)(kg + 8 * lane), g1 = *(const f32x4*)(kg + 8 * lane + 4); u32x4 w;
                w.x = pk2(kf[0] * rk * g0.x, kf[1] * rk * g0.y); w.y = pk2(kf[2] * rk * g0.z, kf[3] * rk * g0.w); w.z = pk2(kf[4] * rk * g1.x, kf[5] * rk * g1.y); w.w = pk2(kf[6] * rk * g1.z, kf[7] * rk * g1.w);
                *(u32x4*)(CKV + (size_t)m * 256 + 8 * lane) = w; }
            if (lane < 16) { const float invf = __builtin_amdgcn_exp2f(-(float)lane * (13.287712379549449f / 16.0f)); const float ang = (float)positions[m] * invf;
                double rev = (double)ang * 0.15915494309189535; rev -= floor(rev); const float rf = (float)rev;
                CS[(size_t)m * 32 + lane] = __builtin_amdgcn_cosf(rf); CS[(size_t)m * 32 + 16 + lane] = __builtin_amdgcn_sinf(rf); }
            const int tpos = m & (SEQ - 1);
#pragma unroll
            for (int hh = 0; hh < 2; ++hh) {
                const int c = 512 * hh + 8 * lane;
                const u32x4 u0 = *(const u32x4*)(UB + (size_t)m * 1024 + c);
                u32x4 u1 = (u32x4){0u, 0u, 0u, 0u}, u2 = (u32x4){0u, 0u, 0u, 0u};
                if (tpos >= 1) u1 = *(const u32x4*)(UB + (size_t)(m - 1) * 1024 + c);
                if (tpos >= 2) u2 = *(const u32x4*)(UB + (size_t)(m - 2) * 1024 + c);
                const u32x4 gb = *(const u32x4*)(GBB + (size_t)m * 1024 + c);
                u32x4 w;
#pragma unroll
                for (int j = 0; j < 4; ++j) {
                    const int e0 = (2 * j) & 3, e1 = (2 * j + 1) & 3, hv = j >> 1;
                    const float za = cwv[hh][0][hv][e0] * bflo(u2[j]) + cwv[hh][1][hv][e0] * bflo(u1[j]) + cwv[hh][2][hv][e0] * bflo(u0[j]);
                    const float zb = cwv[hh][0][hv][e1] * bfhi(u2[j]) + cwv[hh][1][hv][e1] * bfhi(u1[j]) + cwv[hh][2][hv][e1] * bfhi(u0[j]);
                    w[j] = pk2(bflo(gb[j]) * za, bfhi(gb[j]) * zb);
                }
                *(u32x4*)(ZB + (size_t)m * 1024 + c) = w;
            }
        }
    }
    SEAM(5);
    if (IN(6)) {
#ifndef P6_MASK
#define P6_MASK 7
#endif
        if (P6_MASK & 1) { pg8::Gemm g{QN, WUQ, T, 768, 384}; pg8::StaticOrder S; S.init(T, 768, G, bx); pg8::EpiBf16<false> E{QB, 768};
          pg8::gemm_phase<pg8::EpiBf16<false>, pg8::StaticOrder, true, true>(lds, g, S, E); }
        if (P6_MASK & 2) { pg8::Gemm g{CKV, WUK, T, 512, 256}; pg8::StaticOrder S; S.init(T, 512, G, bx); pg8::EpiKnorm E{KB, LAT, CS, (const float*)args.in[15]};
          pg8::gemm_phase<pg8::EpiKnorm, pg8::StaticOrder, true, true>(lds, g, S, E); }
        if (P6_MASK & 4) { pg8::Gemm g{WUV, CKV, 512, T, 256}; pg8::StaticOrder S; S.init(512, T, G, bx); pg8::EpiBf16<false> E{VT, T};
          pg8::gemm_phase<pg8::EpiBf16<false>, pg8::StaticOrder, true, true>(lds, g, S, E); }
    }
    SEAM(6);
#ifndef REP8
#define REP8 1
#endif
    if (IN(8)) {
        for (int rep8 = 0; rep8 < REP8; ++rep8)
        for (int item = bx; item < 256; item += G) {
            const int v = (item % 8) * 32 + item / 8;
            const int s = v & 3, gq2 = v >> 2;
#pragma unroll 1
            for (int i = 0; i < 4; ++i) {
                const int bh = 2 * gq2 + (i >> 1), qb = (i & 1) ? 7 - s : s;
                att::attn_unit(bh >> 3, bh & 7, qb, QB, KB, VT, AO, (const float*)args.in[14], CS, lds);
            }
        }
    }
    SEAM(8);
    if (IN(9)) {
        { pg8::Gemm g{AO, WPA, T, D, 512}; pg8::StaticOrder S; S.init(T, D, G, bx); pg8::EpiGate<false> E{M1, GATES, 2048, nullptr};
          pg8::gemm_phase<pg8::EpiGate<false>, pg8::StaticOrder, true, true>(lds, g, S, E); }
        { pg8::Gemm g{ZB, WPC, T, D, D}; pg8::StaticOrder S; S.init(T, D, G, bx); pg8::EpiGate<true> E{MG, GATES + 1024, 2048, M1};
          pg8::gemm_phase<pg8::EpiGate<true>, pg8::StaticOrder, true, true>(lds, g, S, E); }
    }
    SEAM(9);
    if (IN(10)) {
        pg8::Gemm g{MG, WOUT, T, D, D}; pg8::StaticOrder S; S.init(T, D, G, bx);
        pg8::EpiResF32 E{out, out, D, 1.0f};
        pg8::gemm_phase<pg8::EpiResF32, pg8::StaticOrder, true, true>(lds, g, S, E);
    }
    SEAM(10);
    if (IN(11)) for (int repe = 0; repe < REPE; ++repe) rms_pass(out, (const float*)args.in[20], XN, gw, NGW, lane);
    SEAM(11);
    if (IN(12)) {
        pg8::Gemm g{XN, W2GU, T, 2 * FF, D}; pg8::StaticOrder S; S.init(T, 2 * FF, G, bx);
        pg8::EpiSwiglu E{HB, FF};
        pg8::gemm_phase<pg8::EpiSwiglu, pg8::StaticOrder, true, true>(lds, g, S, E);
    }
    SEAM(12);
    if (IN(13)) {
        pg8::Gemm g{HB, W2D, T, D, FF}; pg8::StaticOrder S; S.init(T, D, G, bx);
        pg8::EpiResF32 E{out, out, D, 0.5f};
        pg8::gemm_phase<pg8::EpiResF32, pg8::StaticOrder, true, true>(lds, g, S, E);
    }
#ifdef EXTRA_SYNCS
    for (int e = 0; e < EXTRA_SYNCS; ++e) xcd_barrier(xbar);
#endif
#undef IN
#undef SEAM
}


#ifndef DUMP
#define DUMP 0
#endif
#if DUMP
__device__ __forceinline__ float ldbf(const bf16* p) { return __uint_as_float(((unsigned)*p) << 16); }
__global__ void dump_kernel(float* out, unsigned char* ws) {
    const bf16* HB = (const bf16*)(ws + WS_H); const bf16* LAT = (const bf16*)(ws + WS_LAT); const bf16* UB = (const bf16*)(ws + WS_U); const bf16* GBB = (const bf16*)(ws + WS_GB);
    const bf16* GATES = (const bf16*)(ws + WS_GATES); const bf16* ZB = (const bf16*)(ws + WS_ZB); const bf16* QN = (const bf16*)(ws + WS_QN); const bf16* CKV = (const bf16*)(ws + WS_CKV);
    const bf16* QB = (const bf16*)(ws + WS_Q); const bf16* KB = (const bf16*)(ws + WS_K); const bf16* VT = (const bf16*)(ws + WS_VT); const bf16* AO = (const bf16*)(ws + WS_AO); const bf16* MG = (const bf16*)(ws + WS_MG);
    for (size_t i = (size_t)blockIdx.x * blockDim.x + threadIdx.x; i < (size_t)T * D; i += (size_t)gridDim.x * blockDim.x) {
        const size_t m = i / D; const int c = (int)(i % D); float v = 0.f;
        if (DUMP == 1) { v = ldbf(HB + m * FF + c) + ldbf(HB + m * FF + 1024 + c) + (c < 768 ? ldbf(HB + m * FF + 2048 + c) : 0.f); }
        if (DUMP == 4) { v = (c < 672 ? ldbf(LAT + m * 768 + c) : 0.f) + ldbf(UB + m * 1024 + c) + ldbf(GBB + m * 1024 + c) + ldbf(GATES + m * 2048 + c) + ldbf(GATES + m * 2048 + 1024 + c); }
        if (DUMP == 5) { v = ldbf(ZB + m * 1024 + c) + ldbf(QN + m * 384 + c % 384) + ldbf(CKV + m * 256 + c % 256); }
        if (DUMP == 7) { v = ldbf(QB + m * 768 + c % 768) + ldbf(KB + m * 768 + c % 768) + ldbf(VT + (size_t)(c % 512) * T + m); }
        if (DUMP == 8) { v = ldbf(AO + m * 512 + c % 512); }
        if (DUMP == 9) { v = ldbf(MG + m * 1024 + c); }
        out[i] = v;
    }
}
#endif
#ifndef MK_ONE_LAUNCH
#define MK_ONE_LAUNCH 0
#endif
extern "C" void kernel_launch(void* const* d_in, const int* in_sizes, int n_in, void* d_out, int out_size, void* d_ws, size_t ws_size, hipStream_t stream) {
    static int grid = 0;
    if (grid == 0) {
        if (n_in != 24 || in_sizes[0] != T * D || out_size != T * D || ws_size < WS_END) { fprintf(stderr, "kernel_launch: unexpected shapes (n_in %d, in0 %d, out %d, ws %zu)\n", n_in, n_in > 0 ? in_sizes[0] : -1, out_size, ws_size); grid = -1; return; }
        int dev = 0, cus = 0, per_cu = 0;
        if (hipGetDevice(&dev) != hipSuccess || hipDeviceGetAttribute(&cus, hipDeviceAttributeMultiprocessorCount, dev) != hipSuccess) { grid = -1; return; }
        if (hipFuncSetAttribute((const void*)fwd_kernel, hipFuncAttributeMaxDynamicSharedMemorySize, LDS_BYTES) != hipSuccess) { fprintf(stderr, "kernel_launch: hipFuncSetAttribute failed\n"); grid = -1; return; }
        if (hipOccupancyMaxActiveBlocksPerMultiprocessor(&per_cu, (const void*)fwd_kernel, NWAVES * 64, LDS_BYTES) != hipSuccess || per_cu < 1) { fprintf(stderr, "kernel_launch: occupancy query says %d\n", per_cu); per_cu = 1; }
        (void)hipGetLastError();
        grid = cus * 1;
    }
    if (grid < 0) return;
    if (hipMemsetAsync(d_ws, 0, 16384, stream) != hipSuccess) { fprintf(stderr, "kernel_launch: memset of the barrier words failed\n"); return; }
    Args a{};
    for (int i = 0; i < 24; ++i) a.in[i] = d_in[i];
    a.out = (float*)d_out; a.ws = (unsigned char*)d_ws;
#if MK_ONE_LAUNCH
    a.ph_lo = 0; a.ph_hi = NPH;
    void* kargs[] = {&a};
    hipError_t e = hipLaunchCooperativeKernel((const void*)fwd_kernel, dim3(grid), dim3(NWAVES * 64), kargs, LDS_BYTES, stream);
    if (e != hipSuccess) fprintf(stderr, "kernel_launch: cooperative launch failed: %s (grid %d)\n", hipGetErrorString(e), grid);
#else
#ifndef STOP_AFTER
#define STOP_AFTER (NPH - 1)
#endif
    for (int p = 0; p <= STOP_AFTER; ++p) {
        a.ph_lo = p; a.ph_hi = p + 1;
        hipLaunchKernelGGL(fwd_kernel, dim3(grid), dim3(NWAVES * 64), LDS_BYTES, stream, a);
    }
#if DUMP
    if (DUMP != 2 && DUMP != 10) hipLaunchKernelGGL(dump_kernel, dim3(2048), dim3(256), 0, stream, (float*)d_out, (unsigned char*)d_ws);
#endif
#endif
}
```
